# Optimizing an MI355X kernel written in HIP

```python
import math
import jax, jax.numpy as jnp
from jax import lax
import numpy as np

D_MODEL = 1024
BATCH = 16
SEQ = 2048
DEPTH = 4

GRID_W = 64
CTX_LEN = 256
N_EVEN = (DEPTH + 1) // 2
N_ODD = DEPTH // 2
EPS = 1e-6
CHUNK = 128
D_A = D_MODEL
A_GROUPS = 8
A_GROUP_DIM = D_A // A_GROUPS
D_B = D_MODEL
HYENA_ORDER = 2
SHORT_CONV = 3
FILTER_EMB = 33
FILTER_BANDS = (FILTER_EMB - 1) // 2
FILTER_HIDDEN = 64
DECAY_TARGET = 1e-2
FAST_DECAY_PCT = 0.3
SLOW_DECAY_PCT = 1.5
MIN_DECAY = math.log(DECAY_TARGET) / SLOW_DECAY_PCT
MAX_DECAY = math.log(DECAY_TARGET) / FAST_DECAY_PCT
D_IN_EVEN = 2 * D_A + (HYENA_ORDER + 1) * D_B
HEAD_DIM = 128
N_HEADS = D_MODEL // HEAD_DIM
N_KV_HEADS = 2
GQA_GROUP = N_HEADS // N_KV_HEADS
Q_BLOCK = 128
ROPE_THETA = 10000.0
D_QKV = (N_HEADS + 2 * N_KV_HEADS) * HEAD_DIM
D_FF = ((8 * D_MODEL + 3 * 256 - 1) // (3 * 256)) * 256

kernel_name = 'hybrid_gmlp_hyena_gqa_prefix_dit'


def rmsnorm(x, g):
    xf = x.astype(jnp.float32)
    y = xf * lax.rsqrt(jnp.mean(xf * xf, axis=-1, keepdims=True) + EPS)
    return (y * g.astype(jnp.float32)).astype(x.dtype)


def layernorm(x, g, b):
    xf = x.astype(jnp.float32)
    mu = jnp.mean(xf, axis=-1, keepdims=True)
    var = jnp.mean(jnp.square(xf - mu), axis=-1, keepdims=True)
    y = (xf - mu) * lax.rsqrt(var + 1e-5)
    return (y * g.astype(jnp.float32) + b.astype(jnp.float32)).astype(x.dtype)


def adaln(cond, w_mod, b_mod):
    return jnp.split(jax.nn.silu(cond) @ w_mod + b_mod, 6, axis=-1)


def modulate(x, g, shift, scale):
    return rmsnorm(x, g) * (1 + scale) + shift


def swiglu(h, w_gu, w_down):
    gate, up = jnp.split(h @ w_gu, 2, axis=-1)
    return (jax.nn.silu(gate) * up) @ w_down


def axial_rope_tables(n):
    rows = n // GRID_W
    row = jnp.repeat(jnp.arange(rows), GRID_W).astype(jnp.float32)
    col = jnp.tile(jnp.arange(GRID_W), rows).astype(jnp.float32)
    half = HEAD_DIM // 2
    inv = ROPE_THETA ** (-jnp.arange(0, half, 2, dtype=jnp.float32) / half)
    ang = jnp.concatenate([row[:, None] * inv, col[:, None] * inv], axis=-1)
    return jnp.cos(ang), jnp.sin(ang)


def apply_rope(x, cos, sin):
    shape = (x.shape[1],) + (1,) * (x.ndim - 3) + (cos.shape[-1],)
    cs, sn = cos.reshape(shape), sin.reshape(shape)
    x1, x2 = jnp.split(x, 2, axis=-1)
    return jnp.concatenate([x1 * cs - x2 * sn, x2 * cs + x1 * sn], axis=-1)


def hyena_filter_freqs(n, w1, b1, w2, b2, w3, freq):
    f32 = jnp.float32
    t = jnp.linspace(0.0, 1.0, n, dtype=f32)[:, None]
    w = (2.0 * math.pi / n) * jnp.arange(n, dtype=f32)[:, None]
    bands = jnp.linspace(1e-4, FILTER_BANDS - 1, FILTER_BANDS, dtype=f32)[None, :]
    ang = bands * w
    z = jnp.concatenate([t, jnp.cos(ang), -jnp.sin(ang)], axis=-1)
    freq = freq.astype(f32)
    hid = jnp.sin(freq[0] * (z @ w1.astype(f32) + b1.astype(f32)))
    hid = jnp.sin(freq[1] * (hid @ w2.astype(f32) + b2.astype(f32)))
    h = (hid @ w3.astype(f32)).reshape(n, 2, HYENA_ORDER, D_B)
    deltas = jnp.abs(jnp.linspace(MIN_DECAY, MAX_DECAY, D_B, dtype=f32))
    h = h * jnp.exp(-t[:, :, None, None] * deltas)
    h_circ = jnp.concatenate(
        [h[:, 0], jnp.zeros((1, HYENA_ORDER, D_B), f32), h[:0:-1, 1]], axis=0)
    h_circ = h_circ / jnp.sum(jnp.abs(h_circ), axis=0, keepdims=True)
    return jnp.fft.rfft(h_circ, axis=0)


def bidir_long_conv(z, h_freq, skip):
    n = z.shape[1]
    zf = z.astype(jnp.float32)
    y = jnp.fft.irfft(jnp.fft.rfft(zf, n=2 * n, axis=1) * h_freq, n=2 * n, axis=1)[:, :n]
    return (y + zf * skip.astype(jnp.float32)).astype(z.dtype)


def centred_short_conv(z, w, b):
    n = z.shape[1]
    pad = SHORT_CONV // 2
    zp = jnp.pad(z, ((0, 0), (pad, pad), (0, 0)))
    return sum(zp[:, k:k + n] * w[k] for k in range(SHORT_CONV)) + b


def gmlp_hyena_mixer(h, h_freq, w_in, ln_g, ln_b, w_s, b_s, conv_w, conv_b, skip, w_out):
    bsz, n, _ = h.shape
    proj = h @ w_in
    u, v = jnp.split(jax.nn.gelu(proj[..., :2 * D_A], approximate=False), 2, axis=-1)
    v = layernorm(v, ln_g, ln_b).reshape(bsz, n // CHUNK, CHUNK, A_GROUPS, A_GROUP_DIM)
    sv = jnp.einsum('gpq,bkqgc->bkpgc', w_s, v) + b_s.T[None, None, :, :, None]
    y_a = u * sv.reshape(bsz, n, D_A)
    hb = centred_short_conv(proj[..., 2 * D_A:], conv_w, conv_b)
    vb, x1, x2 = jnp.split(hb, 3, axis=-1)
    z = x1 * bidir_long_conv(vb, h_freq[:, 0], skip[0])
    z = x2 * bidir_long_conv(z, h_freq[:, 1], skip[1])
    return jnp.concatenate([y_a, z], axis=-1) @ w_out


def gqa_block(q, k, v):
    s = jnp.einsum('bqkgd,bskd->bkgqs', q, k) * (HEAD_DIM ** -0.5)
    p = jax.nn.softmax(s, axis=-1)
    return jnp.einsum('bkgqs,bskd->bqkgd', p, v)


def attention_mixer(h_lat, h_ctx, w_qkv, q_g, k_g, w_o, cos, sin, need_ctx_out):
    def project(h, with_q):
        bsz, n, _ = h.shape
        nq = N_HEADS * HEAD_DIM
        nk = N_KV_HEADS * HEAD_DIM
        w = w_qkv if with_q else w_qkv[:, nq:]
        qkv = h @ w
        off = nq if with_q else 0
        k = rmsnorm(qkv[..., off:off + nk].reshape(bsz, n, N_KV_HEADS, HEAD_DIM), k_g).astype(jnp.float32)
        v = qkv[..., off + nk:].reshape(bsz, n, N_KV_HEADS, HEAD_DIM).astype(jnp.float32)
        q = None
        if with_q:
            q = rmsnorm(qkv[..., :nq].reshape(bsz, n, N_KV_HEADS, GQA_GROUP, HEAD_DIM), q_g).astype(jnp.float32)
        return q, k, v

    bsz, n, _ = h_lat.shape
    q_l, k_l, v_l = project(h_lat, True)
    q_l, k_l = apply_rope(q_l, cos, sin), apply_rope(k_l, cos, sin)
    q_c, k_c, v_c = project(h_ctx, need_ctx_out)
    k_all = jnp.concatenate([k_c, k_l], axis=1)
    v_all = jnp.concatenate([v_c, v_l], axis=1)
    n_blk = n // Q_BLOCK
    q_blocks = q_l.reshape(bsz, n_blk, Q_BLOCK, N_KV_HEADS, GQA_GROUP, HEAD_DIM).swapaxes(0, 1)
    o_l = lax.map(lambda qb: gqa_block(qb, k_all, v_all), q_blocks)
    o_l = o_l.swapaxes(0, 1).reshape(bsz, n, N_HEADS * HEAD_DIM).astype(h_lat.dtype) @ w_o
    o_c = None
    if need_ctx_out:
        n_c = h_ctx.shape[1]
        o_c = gqa_block(q_c, k_c, v_c).reshape(bsz, n_c, N_HEADS * HEAD_DIM).astype(h_ctx.dtype) @ w_o
    return o_l, o_c


def setup_inputs(seed: int = 0) -> dict:
    key = jax.random.key(seed)
    ks = iter(jax.random.split(key, 40))
    f32 = jnp.float32

    def nrm(shape, scale):
        return jax.random.normal(next(ks), shape, f32) * scale

    def gain(shape):
        return 1.0 + nrm(shape, 0.01)

    return {
        'x': nrm((BATCH, SEQ, D_MODEL), 1.0),
        'c': nrm((BATCH, D_MODEL), 1.0),
        'ctx': nrm((BATCH, CTX_LEN, D_MODEL), 1.0),
        'c_ctx': nrm((D_MODEL,), 1.0),
        'mod_w': nrm((DEPTH, D_MODEL, 6 * D_MODEL), 0.5 * D_MODEL ** -0.5),
        'mod_b': nrm((DEPTH, 6 * D_MODEL), 0.01),
        'norm1_g': gain((DEPTH, D_MODEL)),
        'norm2_g': gain((DEPTH, D_MODEL)),
        'ffn_w_gu': nrm((DEPTH, D_MODEL, 2 * D_FF), D_MODEL ** -0.5),
        'ffn_w_down': nrm((DEPTH, D_FF, D_MODEL), D_FF ** -0.5),
        'even_w_in': nrm((N_EVEN, D_MODEL, D_IN_EVEN), D_MODEL ** -0.5),
        'gmlp_ln_g': gain((N_EVEN, D_A)),
        'gmlp_ln_b': nrm((N_EVEN, D_A), 0.01),
        'gmlp_w_s': nrm((N_EVEN, A_GROUPS, CHUNK, CHUNK), CHUNK ** -0.5),
        'gmlp_b_s': gain((N_EVEN, A_GROUPS, CHUNK)),
        'hyena_conv_w': nrm((N_EVEN, SHORT_CONV, (HYENA_ORDER + 1) * D_B), SHORT_CONV ** -0.5),
        'hyena_conv_b': nrm((N_EVEN, (HYENA_ORDER + 1) * D_B), 0.01),
        'hyena_f_w1': nrm((N_EVEN, FILTER_EMB, FILTER_HIDDEN), FILTER_EMB ** -0.5),
        'hyena_f_b1': nrm((N_EVEN, FILTER_HIDDEN), 0.1),
        'hyena_f_w2': nrm((N_EVEN, FILTER_HIDDEN, FILTER_HIDDEN), FILTER_HIDDEN ** -0.5),
        'hyena_f_b2': nrm((N_EVEN, FILTER_HIDDEN), 0.1),
        'hyena_f_w3': nrm((N_EVEN, FILTER_HIDDEN, 2 * HYENA_ORDER * D_B), FILTER_HIDDEN ** -0.5),
        'hyena_freq': gain((N_EVEN, 2, FILTER_HIDDEN)),
        'hyena_skip': nrm((N_EVEN, HYENA_ORDER, D_B), 0.1),
        'even_w_out': nrm((N_EVEN, D_A + D_B, D_MODEL), (D_A + D_B) ** -0.5),
        'attn_w_qkv': nrm((N_ODD, D_MODEL, D_QKV), D_MODEL ** -0.5),
        'attn_q_g': gain((N_ODD, HEAD_DIM)),
        'attn_k_g': gain((N_ODD, HEAD_DIM)),
        'attn_w_o': nrm((N_ODD, N_HEADS * HEAD_DIM, D_MODEL), (N_HEADS * HEAD_DIM) ** -0.5),
        'final_g': gain((D_MODEL,)),
    }


def reference(x, c, ctx, c_ctx, mod_w, mod_b, norm1_g, norm2_g, ffn_w_gu, ffn_w_down,
              even_w_in, gmlp_ln_g, gmlp_ln_b, gmlp_w_s, gmlp_b_s, hyena_conv_w, hyena_conv_b,
              hyena_f_w1, hyena_f_b1, hyena_f_w2, hyena_f_b2, hyena_f_w3, hyena_freq, hyena_skip,
              even_w_out, attn_w_qkv, attn_q_g, attn_k_g, attn_w_o, final_g):
    n = x.shape[1]
    n_ctx = ctx.shape[1]
    cos, sin = axial_rope_tables(n)
    for layer in range(DEPTH):
        last = layer == DEPTH - 1
        is_even = layer % 2 == 0
        ctx_needed = (not last) or (not is_even)
        sh1, sc1, g1, sh2, sc2, g2 = adaln(c[:, None, :], mod_w[layer], mod_b[layer])
        h = modulate(x, norm1_g[layer], sh1, sc1)
        if ctx_needed:
            csh1, csc1, cg1, csh2, csc2, cg2 = adaln(c_ctx, mod_w[layer], mod_b[layer])
            hc = modulate(ctx, norm1_g[layer], csh1, csc1)
        if is_even:
            i = layer // 2
            filt = (hyena_f_w1[i], hyena_f_b1[i], hyena_f_w2[i], hyena_f_b2[i], hyena_f_w3[i], hyena_freq[i])
            prm = (even_w_in[i], gmlp_ln_g[i], gmlp_ln_b[i], gmlp_w_s[i], gmlp_b_s[i],
                   hyena_conv_w[i], hyena_conv_b[i], hyena_skip[i], even_w_out[i])
            y = gmlp_hyena_mixer(h, hyena_filter_freqs(n, *filt), *prm)
            yc = gmlp_hyena_mixer(hc, hyena_filter_freqs(n_ctx, *filt), *prm) if not last else None
        else:
            j = layer // 2
            y, yc = attention_mixer(h, hc, attn_w_qkv[j], attn_q_g[j], attn_k_g[j], attn_w_o[j],
                                    cos, sin, not last)
        x = x + g1 * y
        x = x + g2 * swiglu(modulate(x, norm2_g[layer], sh2, sc2), ffn_w_gu[layer], ffn_w_down[layer])
        if not last:
            ctx = ctx + cg1 * yc
            ctx = ctx + cg2 * swiglu(modulate(ctx, norm2_g[layer], csh2, csc2),
                                     ffn_w_gu[layer], ffn_w_down[layer])
    return rmsnorm(x, final_g)
```

```cpp
#include <hip/hip_runtime.h>
#include <hip/hip_cooperative_groups.h>
#include <hip/hip_bf16.h>
#include <cstdio>
#include <cstdint>
namespace cg = cooperative_groups;

constexpr int DM = 1024, NB = 16, SEQ = 2048, CTXL = 256;
constexpr int NLAT = NB * SEQ, NCTX = NB * CTXL, NTOK = NLAT + NCTX;
constexpr int DFF = 2816, DIN = 5120, DQKV = 1536, SKV = CTXL + SEQ;
constexpr int MODW = 6 * DM;

__device__ __forceinline__ int OTID() { int t = threadIdx.x; asm volatile("" : "+v"(t)); return t; }
__device__ __forceinline__ int OBID() { int t = blockIdx.x; asm volatile("" : "+s"(t)); return t; }

namespace pg8 {
#define PG8_LAS __attribute__((address_space(3)))
typedef unsigned short bf16_t;
typedef short bf16x8 __attribute__((ext_vector_type(8)));
typedef float f32x4 __attribute__((ext_vector_type(4)));
typedef unsigned u32x4 __attribute__((ext_vector_type(4)));
constexpr int BM = 256, BK = 64, HALF = 128, HTB = HALF * BK * 2  , STAGE_BYTES = 8 * HTB, NXCD = 8, WGM = 4;

__host__ __device__ __forceinline__ int lds_byte(int r, int c) { const int st = (r >> 4) * 2 + (c >> 5), rr = r & 15, cc = c & 31, ob = rr * 64 + cc * 2; return st * 1024 + (ob ^ (((ob >> 9) & 1) << 5)); }
__host__ __device__ __forceinline__ void stage_rc(int b, int& R, int& C) { const int st = b / 1024, sb = b % 1024, swz = sb ^ (((sb >> 9) & 1) << 5); R = (st >> 1) * 16 + swz / 64; C = (st & 1) * 32 + (swz % 64) / 2; }
__host__ __device__ __forceinline__ int perm32(int rho) { const int n = rho >> 4, i = rho & 15; return 8 * (i >> 2) + 4 * n + (i & 3); }

struct Unit { int pm, pn; };
struct Gemm { const bf16_t* A; const bf16_t* Bt; int M, N, K; };

struct StaticOrder {
    int nM, nN, nwg, G, c;
    __host__ __device__ void init(int M, int N, int G_, int c_) { nM = M / BM; nN = N / BM; nwg = nM * nN; G = G_; c = c_; }
    __host__ __device__ bool next(int i, Unit& u) const {
        const long L = (long)i * G + c; if (L >= nwg) return false;
        int wgid = (int)L; { const int q = nwg / NXCD, r = nwg % NXCD, xcd = wgid % NXCD, off = wgid / NXCD; wgid = (xcd < r ? xcd * (q + 1) : r * (q + 1) + (xcd - r) * q) + off; }
        const int nig = WGM * nN, gid = wgid / nig, fm = gid * WGM, gsz = (nM - fm) < WGM ? (nM - fm) : WGM;
        u.pm = fm + ((wgid % nig) % gsz); u.pn = (wgid % nig) / gsz; return true;
    }
    __device__ __forceinline__ void a_ready(const Unit&) const {}
    __device__ __forceinline__ void done(const Unit&) const {}
};

__device__ __forceinline__ unsigned cvt_pk_bf16(float lo, float hi) { unsigned r; asm volatile("v_cvt_pk_bf16_f32 %0, %1, %2" : "=v"(r) : "v"(lo), "v"(hi)); return r; }
typedef float f32x2 __attribute__((ext_vector_type(2)));
__device__ __forceinline__ f32x2 gelu_pk(f32x2 v) {
    const f32x2 av = __builtin_elementwise_abs(v), d = av * 0.2316418882f + 1.0f;
    f32x2 t; t.x = __builtin_amdgcn_rcpf(d.x); t.y = __builtin_amdgcn_rcpf(d.y);
    f32x2 q = t * 0.5307027145f + (-0.7265760135f); q = q * t + 0.7107068705f; q = q * t + (-0.142248368f); q = q * t + 0.127414796f; q = q * t;
    const f32x2 s = (v * v) * (-0.72134752044f);
    f32x2 e; e.x = __builtin_amdgcn_exp2f(s.x); e.y = __builtin_amdgcn_exp2f(s.y);
    const f32x2 m = v * (q * e), r = v - m;
    f32x2 o; o.x = v.x < 0.f ? m.x : r.x; o.y = v.y < 0.f ? m.y : r.y; return o;
}
#define PG8_GAS __attribute__((address_space(1)))
__device__ __forceinline__ unsigned short f2bf_rne(float f) { unsigned u = __builtin_bit_cast(unsigned, f); return (unsigned short)((u + 0x7fffu + ((u >> 16) & 1u)) >> 16); }

__device__ __forceinline__ void rows_rinv(float (&rinv)[2][4], const float* ssq, int row0  , int fq) {
    f32x4 p[2][4];
#pragma unroll
    for (int ai = 0; ai < 2; ++ai)
#pragma unroll
        for (int m = 0; m < 4; ++m) p[ai][m] = *(const PG8_GAS f32x4*)(ssq + (size_t)(row0 + ai * HALF + m * 16) * 16 + 4 * fq);
#pragma unroll
    for (int ai = 0; ai < 2; ++ai)
#pragma unroll
        for (int m = 0; m < 4; ++m) { float s = (p[ai][m][0] + p[ai][m][1]) + (p[ai][m][2] + p[ai][m][3]); s += __shfl_xor(s, 16); s += __shfl_xor(s, 32); rinv[ai][m] = rsqrtf(s * (1.f / 1024.f) + 1e-6f); }
}
struct EpiE1 {
    static constexpr bool PERM = true, AFTER_DRAIN = false;
    bf16_t* UV; float* vst; bf16_t* pt_lat; bf16_t* pt_ctx; const float* ssq; const float* bias;
    __device__ __forceinline__ void operator()(const f32x4 (&acc)[2][2][4][2], const Unit& u, int wr, int wc, int fr_, int fq) const {
        int fr = fr_; asm volatile("" : "+v"(fr));
        const float* bp = bias + (size_t)(u.pm < 128 ? (u.pm >> 3) : 16) * 5120 + u.pn * BM + wc * 32 + 8 * fq;
        f32x4 bv[2][2];
#pragma unroll
        for (int bj = 0; bj < 2; ++bj)
#pragma unroll
            for (int n = 0; n < 2; ++n) bv[bj][n] = *(const PG8_GAS f32x4*)(bp + bj * HALF + 4 * n);
        float rv[2][4]; rows_rinv(rv, ssq, u.pm * BM + wr * 64 + fr, fq);
        if (u.pn < 8) {
            const int col0 = u.pn * BM + wc * 32 + 8 * fq;
            const bool isv = u.pn >= 4;
#pragma unroll
            for (int ai = 0; ai < 2; ++ai)
#pragma unroll
                for (int m = 0; m < 4; ++m) {
                    const int row = u.pm * BM + ai * HALF + wr * 64 + m * 16 + fr;
                    const float rinv = rv[ai][m];
                    float s = 0.f, q = 0.f;
#pragma unroll
                    for (int bj = 0; bj < 2; ++bj) {
                        const f32x4 v0 = acc[ai][bj][m][0] * rinv + bv[bj][0], v1 = acc[ai][bj][m][1] * rinv + bv[bj][1];
                        const f32x2 a = gelu_pk((f32x2){v0[0], v0[1]}), b = gelu_pk((f32x2){v0[2], v0[3]}), c = gelu_pk((f32x2){v1[0], v1[1]}), d = gelu_pk((f32x2){v1[2], v1[3]});
                        s += (a.x + a.y) + (b.x + b.y) + (c.x + c.y) + (d.x + d.y);
                        q += (a.x * a.x + a.y * a.y) + (b.x * b.x + b.y * b.y) + (c.x * c.x + c.y * c.y) + (d.x * d.x + d.y * d.y);
                        u32x4 w; w.x = cvt_pk_bf16(a.x, a.y); w.y = cvt_pk_bf16(b.x, b.y); w.z = cvt_pk_bf16(c.x, c.y); w.w = cvt_pk_bf16(d.x, d.y);
                        *(PG8_GAS u32x4*)(UV + (size_t)row * 2048 + col0 + bj * HALF) = w;
                    }
                    if (isv) {
                        s += __shfl_xor(s, 16); s += __shfl_xor(s, 32); q += __shfl_xor(q, 16); q += __shfl_xor(q, 32);
                        if (fq == 0) { f32x2 o; o.x = s; o.y = q; *(PG8_GAS f32x2*)(vst + ((size_t)row * 16 + (u.pn - 4) * 4 + wc) * 2) = o; }
                    }
                }
        } else {
            const int hc0 = (u.pn - 8) * BM + wc * 32 + 8 * fq;
            const bool isctx = u.pm >= 128;
            const int b = isctx ? u.pm - 128 : (u.pm >> 3), t0 = isctx ? 0 : (u.pm & 7) * 256, nseq = isctx ? 256 : 2048;
            bf16_t* base = (isctx ? pt_ctx : pt_lat) + (size_t)b * 3072 * nseq;
#pragma unroll
            for (int ai = 0; ai < 2; ++ai)
#pragma unroll
                for (int m = 0; m < 4; ++m) {
                    const int t = t0 + ai * HALF + wr * 64 + m * 16 + fr;
                    const float rinv = rv[ai][m];
                    const bool odd = (fr & 1) != 0;
#pragma unroll
                    for (int bj = 0; bj < 2; ++bj)
#pragma unroll
                        for (int n = 0; n < 2; ++n) {
                            const f32x4 v = acc[ai][bj][m][n] * rinv + bv[bj][n];
#pragma unroll
                            for (int p = 0; p < 2; ++p) {
                                const float va = v[2 * p], vb = v[2 * p + 1];
                                const float send = odd ? va : vb, mine = odd ? vb : va;
                                const float recv = __builtin_bit_cast(float, __builtin_amdgcn_update_dpp(0, __builtin_bit_cast(int, send), 0xB1, 0xF, 0xF, true));
                                const unsigned w = odd ? cvt_pk_bf16(recv, mine) : cvt_pk_bf16(mine, recv);
                                const int col = hc0 + bj * HALF + 4 * n + 2 * p + (odd ? 1 : 0);
                                *(PG8_GAS unsigned*)(base + (size_t)col * nseq + (odd ? t - 1 : t)) = w;
                            }
                        }
                }
        }
    }
};

struct EpiRes {
    static constexpr bool PERM = false, AFTER_DRAIN = false;
    const float* src_lat; const float* src_ctx; float* dst_lat; float* dst_ctx; const float* gate;
    const float* ng; const float* nsc; bf16_t* xs; float* ssq;
    __device__ __forceinline__ void operator()(const f32x4 (&acc)[2][2][4][2], const Unit& u, int wr, int wc, int fr_, int fq) const {
        int fr = fr_; asm volatile("" : "+v"(fr));
        const bool isctx = u.pm >= 128;
        const int mr = isctx ? 16 : (u.pm >> 3);
        const size_t rb = (size_t)(isctx ? u.pm - 128 : u.pm) * BM * 1024;
        const float* src = (isctx ? src_ctx : src_lat) + rb; float* dst = (isctx ? dst_ctx : dst_lat) + rb;
        const int col0 = u.pn * BM + wc * 32 + 4 * fq;
        const bool nx = ng != nullptr;
        f32x4 gv[2][2], gs[2][2];
#pragma unroll
        for (int bj = 0; bj < 2; ++bj)
#pragma unroll
            for (int n = 0; n < 2; ++n) { gv[bj][n] = *(const PG8_GAS f32x4*)(gate + (size_t)mr * 6144 + col0 + bj * HALF + n * 16);
                gs[bj][n] = nx ? *(const PG8_GAS f32x4*)(ng + col0 + bj * HALF + n * 16) * (*(const PG8_GAS f32x4*)(nsc + (size_t)mr * 6144 + col0 + bj * HALF + n * 16) + 1.f) : (f32x4){0.f, 0.f, 0.f, 0.f}; }
#pragma unroll
        for (int ai = 0; ai < 2; ++ai)
#pragma unroll
          for (int mp = 0; mp < 2; ++mp) {
            f32x4 bs[2][2][2];
#pragma unroll
            for (int mm = 0; mm < 2; ++mm)
#pragma unroll
                for (int bj = 0; bj < 2; ++bj)
#pragma unroll
                    for (int n = 0; n < 2; ++n) bs[mm][bj][n] = *(const PG8_GAS f32x4*)(src + (size_t)(ai * HALF + wr * 64 + (2 * mp + mm) * 16 + fr) * 1024 + col0 + bj * HALF + n * 16);
#pragma unroll
            for (int mm = 0; mm < 2; ++mm) {
                const int m = 2 * mp + mm;
                const int r = ai * HALF + wr * 64 + m * 16 + fr;
                const size_t off = (size_t)r * 1024 + col0;
                const size_t grow = (size_t)u.pm * BM + r;
                float q = 0.f;
#pragma unroll
                for (int bj = 0; bj < 2; ++bj)
#pragma unroll
                    for (int n = 0; n < 2; ++n) { const f32x4 xn = bs[mm][bj][n] + gv[bj][n] * acc[ai][bj][m][n];
                        *(PG8_GAS f32x4*)(dst + off + bj * HALF + n * 16) = xn;
                        if (nx) { q += (xn[0] * xn[0] + xn[1] * xn[1]) + (xn[2] * xn[2] + xn[3] * xn[3]); const f32x4 y = xn * gs[bj][n];
                            typedef unsigned u32x2v __attribute__((ext_vector_type(2))); u32x2v w; w.x = cvt_pk_bf16(y[0], y[1]); w.y = cvt_pk_bf16(y[2], y[3]);
                            *(PG8_GAS u32x2v*)(xs + grow * 1024 + col0 + bj * HALF + n * 16) = w; } }
                if (nx) { q += __shfl_xor(q, 16); q += __shfl_xor(q, 32); if (fq == 0) ((PG8_GAS float*)ssq)[grow * 16 + u.pn * 4 + wc] = q; }
            }
            asm volatile("" ::: "memory");
          }
    }
};

struct EpiSwiGLU {
    static constexpr bool PERM = true, AFTER_DRAIN = false;
    bf16_t* act; const float* ssq; const float* bias;
    __device__ __forceinline__ void operator()(const f32x4 (&acc)[2][2][4][2], const Unit& u, int wr, int wc, int fr_, int fq) const {
        int fr = fr_; asm volatile("" : "+v"(fr));
        const int j0 = u.pn * 128 + wc * 16 + 4 * fq;
        const float* bp = bias + (size_t)(u.pm < 128 ? (u.pm >> 3) : 16) * 5632 + j0;
        f32x4 bg[2], bu[2];
#pragma unroll
        for (int bj = 0; bj < 2; ++bj) { bg[bj] = *(const PG8_GAS f32x4*)(bp + bj * 64); bu[bj] = *(const PG8_GAS f32x4*)(bp + 2816 + bj * 64); }
        float rv[2][4]; rows_rinv(rv, ssq, u.pm * BM + wr * 64 + fr, fq);
#pragma unroll
        for (int ai = 0; ai < 2; ++ai)
#pragma unroll
            for (int m = 0; m < 4; ++m) {
                const int row = u.pm * BM + ai * HALF + wr * 64 + m * 16 + fr;
                const float rinv = rv[ai][m];
#pragma unroll
                for (int bj = 0; bj < 2; ++bj) {
                    const f32x4 v0 = acc[ai][bj][m][0] * rinv + (f32x4){bg[bj][0], bu[bj][0], bg[bj][1], bu[bj][1]}, v1 = acc[ai][bj][m][1] * rinv + (f32x4){bg[bj][2], bu[bj][2], bg[bj][3], bu[bj][3]};
                    const float a0 = v0[0] * __builtin_amdgcn_rcpf(1.f + __expf(-v0[0])) * v0[1];
                    const float a1 = v0[2] * __builtin_amdgcn_rcpf(1.f + __expf(-v0[2])) * v0[3];
                    const float a2 = v1[0] * __builtin_amdgcn_rcpf(1.f + __expf(-v1[0])) * v1[1];
                    const float a3 = v1[2] * __builtin_amdgcn_rcpf(1.f + __expf(-v1[2])) * v1[3];
                    typedef unsigned u32x2v __attribute__((ext_vector_type(2)));
                    u32x2v w; w.x = cvt_pk_bf16(a0, a1); w.y = cvt_pk_bf16(a2, a3);
                    *(PG8_GAS u32x2v*)(act + (size_t)row * 2816 + j0 + bj * 64) = w;
                }
            }
    }
};

struct EpiQKV {
    static constexpr bool PERM = true, AFTER_DRAIN = false;
    bf16_t* Q; bf16_t* Kb; bf16_t* Vb; const float* ssq; const float* bias;
    __device__ __forceinline__ void operator()(const f32x4 (&acc)[2][2][4][2], const Unit& u, int wr, int wc, int fr_, int fq) const {
        int fr = fr_; asm volatile("" : "+v"(fr));
        bf16_t* base; int ld;
        if (u.pn < 4) { base = Q + (size_t)u.pm * BM * 1024 + u.pn * BM; ld = 1024; }
        else { const int kvrow = (u.pm < 128) ? (u.pm >> 3) * 2304 + 256 + (u.pm & 7) * 256 : (u.pm - 128) * 2304; base = (u.pn == 4 ? Kb : Vb) + (size_t)kvrow * 256; ld = 256; }
        const int col0 = wc * 32 + 8 * fq;
        const float* bp = bias + (size_t)(u.pm < 128 ? (u.pm >> 3) : 16) * 1536 + u.pn * BM + col0;
        f32x4 bv[2][2];
#pragma unroll
        for (int bj = 0; bj < 2; ++bj)
#pragma unroll
            for (int n = 0; n < 2; ++n) bv[bj][n] = *(const PG8_GAS f32x4*)(bp + bj * HALF + 4 * n);
        float rv[2][4]; rows_rinv(rv, ssq, u.pm * BM + wr * 64 + fr, fq);
#pragma unroll
        for (int ai = 0; ai < 2; ++ai)
#pragma unroll
            for (int m = 0; m < 4; ++m) {
                bf16_t* rowp = base + (size_t)(ai * HALF + wr * 64 + m * 16 + fr) * ld + col0;
                const float rinv = rv[ai][m];
#pragma unroll
                for (int bj = 0; bj < 2; ++bj) {
                    const f32x4 v0 = acc[ai][bj][m][0] * rinv + bv[bj][0], v1 = acc[ai][bj][m][1] * rinv + bv[bj][1];
                    u32x4 w; w.x = cvt_pk_bf16(v0[0], v0[1]); w.y = cvt_pk_bf16(v0[2], v0[3]); w.z = cvt_pk_bf16(v1[0], v1[1]); w.w = cvt_pk_bf16(v1[2], v1[3]);
                    *(PG8_GAS u32x4*)(rowp + bj * HALF) = w;
                }
            }
    }
};

template <class Epi, class Sched, bool ALIGN_EPI = false, bool SP2 = false>
__device__ __forceinline__ void gemm_phase(PG8_LAS unsigned char* lds, const Gemm g, const Sched& S, const Epi& E) {
    const int tid = OTID(), wid = __builtin_amdgcn_readfirstlane(tid >> 6), lane = tid & 63, wr = wid >> 2, wc = wid & 3, fr = lane & 15, fq = lane >> 4;
    const int K = g.K, nt = K / BK;
    unsigned voffA[2], voffB[2];
#pragma unroll
    for (int i = 0; i < 2; ++i) { int R, C; stage_rc(tid * 16 + i * 8192, R, C); const int Rb = Epi::PERM ? ((R & ~31) + perm32(R & 31)) : R;
        voffA[i] = (unsigned)(R * K + C) * 2u; voffB[i] = (unsigned)(Rb * K + C) * 2u; }
    const size_t kstep = (size_t)(BK * 2);
    const size_t hstep = (size_t)HALF * K * 2;
    const size_t tstep = 2 * hstep;
    const unsigned ldsw = (unsigned)wid * 1024u;
    const int aoff = lds_byte(wr * 64 + fr, fq * 8), boff = lds_byte(wc * 32 + fr, fq * 8);
#define PG8_SA(b, h) (((b) * 2 + (h)) * HTB)
#define PG8_SB(b, h) ((4 + (b) * 2 + (h)) * HTB)
#define PG8_STAGE(bufoff, gbase, voff) do { _Pragma("unroll") for (int _i = 0; _i < 2; ++_i) \
        __builtin_amdgcn_global_load_lds((const unsigned*)((const char*)(gbase) + (voff)[_i]), (PG8_LAS unsigned*)(lds + (bufoff) + ldsw + _i * 8192), 16, 0, 0); } while (0)
#define PG8_LDA(dst, b, h) do { _Pragma("unroll") for (int m = 0; m < 4; ++m) _Pragma("unroll") for (int k = 0; k < 2; ++k) dst[m][k] = *(const PG8_LAS bf16x8*)(lds + PG8_SA(b, h) + aoff + m * 2048 + k * 1024); } while (0)
#define PG8_LDB(dst, b, h) do { _Pragma("unroll") for (int n = 0; n < 2; ++n) _Pragma("unroll") for (int k = 0; k < 2; ++k) dst[n][k] = *(const PG8_LAS bf16x8*)(lds + PG8_SB(b, h) + boff + n * 2048 + k * 1024); } while (0)
#define PG8_MMA(ai, bj, At, Bt) do { __builtin_amdgcn_s_setprio(1); _Pragma("unroll") for (int m = 0; m < 4; ++m) _Pragma("unroll") for (int n = 0; n < 2; ++n) _Pragma("unroll") for (int k = 0; k < 2; ++k) \
        acc[ai][bj][m][n] = __builtin_amdgcn_mfma_f32_16x16x32_bf16(Bt[n][k], At[m][k], acc[ai][bj][m][n], 0, 0, 0); __builtin_amdgcn_s_setprio(0); } while (0)
#define PG8_WAIT_V(n) asm volatile("s_waitcnt vmcnt(" #n ")" ::: "memory")
#define PG8_WAIT_L(n) asm volatile("s_waitcnt lgkmcnt(" #n ")" ::: "memory")
#define PG8_BAR __builtin_amdgcn_s_barrier()
#define PG8_SCHED __builtin_amdgcn_sched_barrier(0)
    Unit cur, nxt; int ui = 0;
    if (!S.next(0, cur)) return;
    f32x4 acc[2][2][4][2];
#pragma unroll
    for (int a = 0; a < 2; ++a)
#pragma unroll
        for (int b = 0; b < 2; ++b)
#pragma unroll
            for (int m = 0; m < 4; ++m)
#pragma unroll
                for (int n = 0; n < 2; ++n) acc[a][b][m][n] = (f32x4){0.f, 0.f, 0.f, 0.f};
    bf16x8 At[4][2], B0[2][2], B1[2][2];
    const char* cA = (const char*)g.A + (size_t)cur.pm * tstep; const char* cB = (const char*)g.Bt + (size_t)cur.pn * tstep;
    S.a_ready(cur);
    if constexpr (SP2) {
        PG8_STAGE(PG8_SB(0, 0), cB, voffB); PG8_STAGE(PG8_SB(0, 1), cB + hstep, voffB); PG8_STAGE(PG8_SA(0, 0), cA, voffA); PG8_STAGE(PG8_SA(0, 1), cA + hstep, voffA);
        if (wr == 1) PG8_BAR;
        PG8_WAIT_V(2); PG8_BAR;
        PG8_STAGE(PG8_SB(1, 0), cB + kstep, voffB); PG8_STAGE(PG8_SA(1, 0), cA + kstep, voffA); PG8_STAGE(PG8_SB(1, 1), cB + hstep + kstep, voffB);
        PG8_WAIT_V(6); PG8_BAR;
    } else {
        PG8_STAGE(PG8_SB(0, 0), cB, voffB); PG8_STAGE(PG8_SA(0, 0), cA, voffA); PG8_STAGE(PG8_SB(0, 1), cB + hstep, voffB); PG8_STAGE(PG8_SA(0, 1), cA + hstep, voffA);
        if (wr == 1) PG8_BAR;
        PG8_WAIT_V(4); PG8_BAR;
        PG8_STAGE(PG8_SB(1, 0), cB + kstep, voffB); PG8_STAGE(PG8_SA(1, 0), cA + kstep, voffA); PG8_STAGE(PG8_SB(1, 1), cB + hstep + kstep, voffB);
        PG8_WAIT_V(6); PG8_BAR;
    }
    for (;;) {
        const bool has_next = S.next(ui + 1, nxt);
        const char* nA = has_next ? (const char*)g.A + (size_t)nxt.pm * tstep : cA; const char* nB = has_next ? (const char*)g.Bt + (size_t)nxt.pn * tstep : cB;
        for (int t = 0; t < nt; t += 2) {
            const bool last = (t == nt - 2);
            const char* a1 = cA + (size_t)(t + 1) * kstep;
            const char* a2 = last ? nA : cA + (size_t)(t + 2) * kstep; const char* b2 = last ? nB : cB + (size_t)(t + 2) * kstep;
            const char* a3 = a2 + kstep; const char* b3 = b2 + kstep;
            if (last && has_next) S.a_ready(nxt);
            if constexpr (SP2) {
            PG8_LDB(B0, 0, 0); PG8_LDB(B1, 0, 1); PG8_SCHED; PG8_LDA(At, 0, 0); PG8_STAGE(PG8_SA(1, 1), a1 + hstep, voffA);
            PG8_WAIT_V(8); PG8_WAIT_L(0); PG8_BAR; PG8_MMA(0, 0, At, B0); PG8_MMA(0, 1, At, B1); PG8_BAR; PG8_SCHED;
            PG8_LDA(At, 0, 1); PG8_STAGE(PG8_SB(0, 0), b2, voffB); PG8_STAGE(PG8_SB(0, 1), b2 + hstep, voffB); PG8_STAGE(PG8_SA(0, 0), a2, voffA);
            PG8_WAIT_V(8); PG8_WAIT_L(0); PG8_BAR; PG8_MMA(1, 0, At, B0); PG8_MMA(1, 1, At, B1); PG8_BAR; PG8_SCHED;
            PG8_LDB(B0, 1, 0); PG8_LDB(B1, 1, 1); PG8_SCHED; PG8_LDA(At, 1, 0); PG8_STAGE(PG8_SA(0, 1), a2 + hstep, voffA);
            PG8_WAIT_V(8); PG8_WAIT_L(0); PG8_BAR; PG8_MMA(0, 0, At, B0); PG8_MMA(0, 1, At, B1); PG8_BAR; PG8_SCHED;
            PG8_LDA(At, 1, 1); PG8_STAGE(PG8_SB(1, 0), b3, voffB); PG8_STAGE(PG8_SB(1, 1), b3 + hstep, voffB); PG8_STAGE(PG8_SA(1, 0), a3, voffA);
            PG8_WAIT_V(8); PG8_WAIT_L(0); PG8_BAR; PG8_MMA(1, 0, At, B0); PG8_MMA(1, 1, At, B1); PG8_BAR; PG8_SCHED;
            } else {
            PG8_LDB(B0, 0, 0); PG8_SCHED; PG8_LDA(At, 0, 0); PG8_STAGE(PG8_SA(1, 1), a1 + hstep, voffA);
            PG8_WAIT_L(8); PG8_BAR; PG8_WAIT_L(0); PG8_MMA(0, 0, At, B0); PG8_BAR; PG8_SCHED;
            PG8_LDB(B1, 0, 1); PG8_STAGE(PG8_SB(0, 0), b2, voffB);
            PG8_BAR; PG8_WAIT_L(0); PG8_MMA(0, 1, At, B1); PG8_BAR;
            PG8_LDA(At, 0, 1); PG8_STAGE(PG8_SA(0, 0), a2, voffA);
            PG8_BAR; PG8_WAIT_L(0); PG8_MMA(1, 0, At, B0); PG8_BAR; PG8_SCHED;
            PG8_STAGE(PG8_SB(0, 1), b2 + hstep, voffB);
            PG8_WAIT_V(6); PG8_BAR; PG8_MMA(1, 1, At, B1); PG8_BAR;
            PG8_LDB(B0, 1, 0); PG8_SCHED; PG8_LDA(At, 1, 0); PG8_STAGE(PG8_SA(0, 1), a2 + hstep, voffA);
            PG8_WAIT_L(8); PG8_BAR; PG8_WAIT_L(0); PG8_MMA(0, 0, At, B0); PG8_BAR; PG8_SCHED;
            PG8_LDB(B1, 1, 1); PG8_STAGE(PG8_SB(1, 0), b3, voffB);
            PG8_BAR; PG8_WAIT_L(0); PG8_MMA(0, 1, At, B1); PG8_BAR;
            PG8_LDA(At, 1, 1); PG8_STAGE(PG8_SA(1, 0), a3, voffA);
            PG8_BAR; PG8_WAIT_L(0); PG8_MMA(1, 0, At, B0); PG8_BAR; PG8_SCHED;
            PG8_STAGE(PG8_SB(1, 1), b3 + hstep, voffB);
            PG8_WAIT_V(6); PG8_BAR; PG8_MMA(1, 1, At, B1); PG8_BAR;
            }
        }
        if constexpr (ALIGN_EPI) { if (wr == 0) PG8_BAR; }
        if constexpr (!Epi::AFTER_DRAIN) { E(acc, cur, wr, wc, fr, fq); S.done(cur); }
        if (!has_next) break;
#pragma unroll
        for (int a = 0; a < 2; ++a)
#pragma unroll
            for (int b = 0; b < 2; ++b)
#pragma unroll
                for (int m = 0; m < 4; ++m)
#pragma unroll
                    for (int n = 0; n < 2; ++n) acc[a][b][m][n] = (f32x4){0.f, 0.f, 0.f, 0.f};
        cur = nxt; cA = nA; cB = nB; ++ui;
        if constexpr (ALIGN_EPI) { if (wr == 1) PG8_BAR; }
    }
    PG8_WAIT_V(0);
    if constexpr (!ALIGN_EPI) { if (wr == 0) PG8_BAR; }
    PG8_BAR;
    if constexpr (Epi::AFTER_DRAIN) { E.fused(acc, cur, wr, wc, fr, fq, lds, wid, lane); S.done(cur); }
#undef PG8_SA
#undef PG8_SB
#undef PG8_STAGE
#undef PG8_LDA
#undef PG8_LDB
#undef PG8_MMA
#undef PG8_WAIT_V
#undef PG8_WAIT_L
#undef PG8_BAR
#undef PG8_SCHED
}
}
namespace att {
using bf16 = __hip_bfloat16;
constexpr int   D = 128, NW = 8, QBLK = 32, KVBLK = 64;
constexpr float SCALE = 0.088388347648318440f;
constexpr float THR = 8.f;
constexpr int SDEPTH = 2;
constexpr int LDQ = 1024, LDK = 256, LDO = 1024;
constexpr size_t SHM_V = KVBLK * D * 2, SHM_K = KVBLK * D * 2, SHM_ATTN = 2 * SHM_V + 2 * SHM_K + NW * 64 * 4;
using bf16x8 = __attribute__((ext_vector_type(8))) short;
using s16x4  = __attribute__((ext_vector_type(4))) short;
using f32x16 = __attribute__((ext_vector_type(16))) float;
using f32x8  = __attribute__((ext_vector_type(8))) float;
using u32x4  = __attribute__((ext_vector_type(4))) unsigned;
#define KSWZ(row, colB) ((row) * 256 + ((colB) ^ (((row) & 7) << 4)))
#define SBAR() __builtin_amdgcn_sched_barrier(0)
__device__ __forceinline__ int crow(int r, int hi) { return (r & 3) + 8 * (r >> 2) + 4 * hi; }
__device__ __forceinline__ unsigned cvtpk(float lo, float hi) {
  unsigned r; asm volatile("v_cvt_pk_bf16_f32 %0, %1, %2" : "=v"(r) : "v"(lo), "v"(hi)); return r;
}
template <typename TIn> struct Stage;
template <> struct Stage<bf16>  { using T = bf16x8;
  __device__ static __forceinline__ T ld8(const bf16* p) { return *(const __attribute__((address_space(1))) bf16x8*)(p); }
  __device__ static __forceinline__ bf16x8 tobf(T x) { return x; } };
template <> struct Stage<float> { using T = f32x8;
  __device__ static __forceinline__ T ld8(const float* p) { return *reinterpret_cast<const f32x8*>(p); }
  __device__ static __forceinline__ bf16x8 tobf(T x) {
    u32x4 w = {cvtpk(x[0], x[1]), cvtpk(x[2], x[3]), cvtpk(x[4], x[5]), cvtpk(x[6], x[7])}; return *reinterpret_cast<bf16x8*>(&w); } };

__device__ __forceinline__ void partialSM(f32x16& p0, f32x16& p1, float& m_reg, float& mn, float& alpha) {
  constexpr float C = SCALE * 1.4426950408889634f;
  float pmax = p0[0]; for (int r = 1; r < 16; ++r) pmax = fmaxf(pmax, p0[r]); for (int r = 0; r < 16; ++r) pmax = fmaxf(pmax, p1[r]);
  { auto rr = __builtin_amdgcn_permlane32_swap(__float_as_uint(pmax), __float_as_uint(pmax), false, false);
    pmax = fmaxf(__uint_as_float(rr[0]), __uint_as_float(rr[1])); }
  if (__builtin_expect(__all(pmax - m_reg <= THR / SCALE), 1)) { mn = m_reg; alpha = 1.f; }
  else { mn = fmaxf(m_reg, pmax); alpha = __builtin_amdgcn_exp2f((m_reg - mn) * C); m_reg = mn; }
  float mnC = -mn * C;
  for (int r = 0; r < 16; ++r) p0[r] = fmaf(p0[r], C, mnC); for (int r = 0; r < 16; ++r) p1[r] = fmaf(p1[r], C, mnC);
  for (int r = 0; r < 16; ++r) p0[r] = __builtin_amdgcn_exp2f(p0[r]);
}
__device__ __forceinline__ void finishSM(f32x16& p0, f32x16& p1, float alpha, float& l_reg, bf16x8& pa0, bf16x8& pa1, bf16x8& pa2, bf16x8& pa3) {
  for (int r = 0; r < 16; ++r) p1[r] = __builtin_amdgcn_exp2f(p1[r]);
  float ps = 0; for (int r = 0; r < 16; ++r) ps += p0[r]; for (int r = 0; r < 16; ++r) ps += p1[r];
  { auto rr = __builtin_amdgcn_permlane32_swap(__float_as_uint(ps), __float_as_uint(ps), false, false);
    ps = __uint_as_float(rr[0]) + __uint_as_float(rr[1]); }
  l_reg = l_reg * alpha + ps;
#define PK4(P, BASE, OUT) do { unsigned a0 = cvtpk(P[BASE + 0], P[BASE + 1]), a1 = cvtpk(P[BASE + 2], P[BASE + 3]);   \
    unsigned b0 = cvtpk(P[BASE + 4], P[BASE + 5]), b1 = cvtpk(P[BASE + 6], P[BASE + 7]);                              \
    auto r0 = __builtin_amdgcn_permlane32_swap(a0, b0, false, false); auto r1 = __builtin_amdgcn_permlane32_swap(a1, b1, false, false); \
    u32x4 w = {r0[0], r1[0], r0[1], r1[1]}; OUT = *reinterpret_cast<bf16x8*>(&w); } while (0)
  PK4(p0, 0, pa0); PK4(p0, 8, pa1); PK4(p1, 0, pa2); PK4(p1, 8, pa3);
#undef PK4
}
__device__ __forceinline__ void qkt(f32x16& p0, f32x16& p1, const bf16* Ks, const bf16x8* qr, int r32, int hi) {
  p0 = f32x16{}; p1 = f32x16{};
  for (int d0 = 0; d0 < 8; ++d0) { int cb = (d0 * 16 + hi * 8) * 2;
    bf16x8 b0 = *reinterpret_cast<const bf16x8*>((const char*)Ks + KSWZ(r32, cb));
    bf16x8 b1 = *reinterpret_cast<const bf16x8*>((const char*)Ks + KSWZ(32 + r32, cb));
    p0 = __builtin_amdgcn_mfma_f32_32x32x16_bf16(b0, qr[d0], p0, 0, 0, 0);
    p1 = __builtin_amdgcn_mfma_f32_32x32x16_bf16(b1, qr[d0], p1, 0, 0, 0); }
}
__device__ __forceinline__ int v_st(int k, int c) { const int kk = (k & ~0xC) | ((k & 4) << 1) | ((k & 8) >> 1); return ((kk >> 3) * 4 + (c >> 5)) * 512 + ((kk & 7) * 32 + (c & 31)) * 2; }
__device__ __forceinline__ int v_rd_base(int lane) { return ((lane & 3) << 3) | (((lane >> 2) & 3) << 6) | (((lane >> 4) & 1) << 5) | (((lane >> 5) & 1) << 8); }
constexpr int v_rd_off(int d0, int ks, int half) { return d0 * 512 + ks * 4096 + half * 2048; }
template <int OFF> __device__ __forceinline__ s16x4 tr_read(int vb) {
  s16x4 r; asm volatile("ds_read_b64_tr_b16 %0, %1 offset:%2" : "=&v"(r) : "v"(vb), "i"(OFF) : "memory"); return r;
}
template <int D0> __device__ __forceinline__ void pv_one(f32x16& od, int vb, bf16x8 pa0, bf16x8 pa1, bf16x8 pa2, bf16x8 pa3) {
  const s16x4 l0 = tr_read<v_rd_off(D0, 0, 0)>(vb), h0 = tr_read<v_rd_off(D0, 0, 1)>(vb), l1 = tr_read<v_rd_off(D0, 1, 0)>(vb), h1 = tr_read<v_rd_off(D0, 1, 1)>(vb);
  const s16x4 l2 = tr_read<v_rd_off(D0, 2, 0)>(vb), h2 = tr_read<v_rd_off(D0, 2, 1)>(vb), l3 = tr_read<v_rd_off(D0, 3, 0)>(vb), h3 = tr_read<v_rd_off(D0, 3, 1)>(vb);
  asm volatile("s_waitcnt lgkmcnt(0)" ::: "memory"); SBAR();
#define PK(L, H) (bf16x8){L[0], L[1], L[2], L[3], H[0], H[1], H[2], H[3]}
  od = __builtin_amdgcn_mfma_f32_32x32x16_bf16(pa0, PK(l0, h0), od, 0, 0, 0);
  od = __builtin_amdgcn_mfma_f32_32x32x16_bf16(pa1, PK(l1, h1), od, 0, 0, 0);
  od = __builtin_amdgcn_mfma_f32_32x32x16_bf16(pa2, PK(l2, h2), od, 0, 0, 0);
  od = __builtin_amdgcn_mfma_f32_32x32x16_bf16(pa3, PK(l3, h3), od, 0, 0, 0);
#undef PK
}
__device__ __forceinline__ void pv_d0(f32x16* o, int vb, bf16x8 pa0, bf16x8 pa1, bf16x8 pa2, bf16x8 pa3) {
  pv_one<0>(o[0], vb, pa0, pa1, pa2, pa3); pv_one<1>(o[1], vb, pa0, pa1, pa2, pa3); pv_one<2>(o[2], vb, pa0, pa1, pa2, pa3); pv_one<3>(o[3], vb, pa0, pa1, pa2, pa3);
}

template <typename TQ>
__device__ __forceinline__ void attn_dense_body(const TQ* __restrict__ Qb, const bf16* __restrict__ Kh, const bf16* __restrict__ Vh,
                                                bf16* __restrict__ Ob, int seq, char* lds, const float* __restrict__ qg, int pos0) {
  using St = Stage<bf16>; using SQ = Stage<TQ>;
  const int tid = OTID(), wid = tid >> 6, lane = tid & 63, r32 = lane & 31, hi = lane >> 5;
  bf16* V_lds = (bf16*)lds; bf16* K_lds = (bf16*)(lds + 2 * SHM_V);
  float* ws = (float*)(lds + 2 * SHM_V + 2 * SHM_K) + wid * 64; float* li_l = ws; float* al_l = ws + 32;
  float m_reg = -1e30f, l_reg = 0; f32x16 o[4] = {}; bf16x8 qr[8];
  const TQ* Qw = Qb + (long)(wid * QBLK + r32) * LDQ + hi * 8;
#pragma unroll
  for (int d0 = 0; d0 < 8; ++d0) qr[d0] = SQ::tobf(SQ::ld8(Qw + d0 * 16));
  {
    float qf[8][8]; float ss = 0.f;
#pragma unroll
    for (int d0 = 0; d0 < 8; ++d0)
#pragma unroll
      for (int e = 0; e < 8; ++e) { const float v = __builtin_bit_cast(float, (unsigned)(unsigned short)qr[d0][e] << 16); qf[d0][e] = v; ss += v * v; }
    { auto rr = __builtin_amdgcn_permlane32_swap(__float_as_uint(ss), __float_as_uint(ss), false, false); ss = __uint_as_float(rr[0]) + __uint_as_float(rr[1]); }
    const float rinv = rsqrtf(ss * (1.f / 128.f) + 1e-6f);
#pragma unroll
    for (int d0 = 0; d0 < 8; ++d0) {
      const float4 g0 = *reinterpret_cast<const float4*>(qg + d0 * 16 + hi * 8), g1 = *reinterpret_cast<const float4*>(qg + d0 * 16 + hi * 8 + 4);
      qf[d0][0] *= rinv * g0.x; qf[d0][1] *= rinv * g0.y; qf[d0][2] *= rinv * g0.z; qf[d0][3] *= rinv * g0.w;
      qf[d0][4] *= rinv * g1.x; qf[d0][5] *= rinv * g1.y; qf[d0][6] *= rinv * g1.z; qf[d0][7] *= rinv * g1.w;
    }
    if (pos0 >= 0) {
      const int t = pos0 + wid * QBLK + r32; const float prow = (float)(t >> 6), pcol = (float)(t & 63);
#pragma unroll
      for (int d0 = 0; d0 < 4; ++d0)
#pragma unroll
        for (int e = 0; e < 8; ++e) {
          const int i = d0 * 16 + hi * 8 + e;
          const float inv = exp2f(-(float)(i & 31) * (13.287712379549449f / 32.f));
          const float ang = (d0 < 2 ? prow : pcol) * inv; const float cs = __cosf(ang), sn = __sinf(ang);
          const float x1 = qf[d0][e], x2 = qf[d0 + 4][e];
          qf[d0][e] = x1 * cs - x2 * sn; qf[d0 + 4][e] = x2 * cs + x1 * sn;
        }
    }
#pragma unroll
    for (int d0 = 0; d0 < 8; ++d0) { u32x4 w = {cvtpk(qf[d0][0], qf[d0][1]), cvtpk(qf[d0][2], qf[d0][3]), cvtpk(qf[d0][4], qf[d0][5]), cvtpk(qf[d0][6], qf[d0][7])}; qr[d0] = *reinterpret_cast<bf16x8*>(&w); }
  }
  const int sr = tid >> 4, sc = (tid & 15) * 8, vst0 = v_st(sr, sc), vst1 = v_st(32 + sr, sc);
  const int vb0 = (int)(uintptr_t)V_lds + v_rd_base(lane);
  struct { typename St::T vs0, vs1, ks0, ks1; } sr_[SDEPTH];
#define SLOAD(i, k0) do { sr_[i].vs0 = St::ld8(&Vh[(long)((k0) + sr) * LDK + sc]); sr_[i].vs1 = St::ld8(&Vh[(long)((k0) + 32 + sr) * LDK + sc]); \
    sr_[i].ks0 = St::ld8(&Kh[(long)((k0) + sr) * LDK + sc]); sr_[i].ks1 = St::ld8(&Kh[(long)((k0) + 32 + sr) * LDK + sc]); } while (0)
#define SWRITE(b, i) do { *(bf16x8*)((char*)V_lds + (b) * SHM_V + vst0) = St::tobf(sr_[i].vs0);          \
    *(bf16x8*)((char*)V_lds + (b) * SHM_V + vst1) = St::tobf(sr_[i].vs1); int kc = sc * 2;               \
    *(bf16x8*)((char*)K_lds + (b) * SHM_K + KSWZ(sr, kc)) = St::tobf(sr_[i].ks0);                       \
    *(bf16x8*)((char*)K_lds + (b) * SHM_K + KSWZ(32 + sr, kc)) = St::tobf(sr_[i].ks1); } while (0)
#define SWAIT() do { if constexpr (SDEPTH == 2) asm volatile("s_waitcnt vmcnt(4)" ::: "memory"); else asm volatile("s_waitcnt vmcnt(0)" ::: "memory"); } while (0)
#define RESC(a) do { if (__any((a) < 1.f)) { if (hi == 0) al_l[r32] = (a); asm volatile("s_waitcnt lgkmcnt(0)" ::: "memory"); \
    for (int d = 0; d < 4; ++d) for (int r = 0; r < 16; ++r) o[d][r] *= al_l[crow(r, hi)]; } } while (0)
  f32x16 pA0, pA1, pB0, pB1; float mnA, mnB, alA, alB; bf16x8 pa0, pa1, pa2, pa3; const int NT = seq / KVBLK;
  constexpr int SE = 0, SO = SDEPTH - 1;
  SLOAD(SE, 0); asm volatile("s_waitcnt vmcnt(0)" ::: "memory"); SWRITE(0, SE); __syncthreads();
  qkt(pA0, pA1, K_lds, qr, r32, hi); partialSM(pA0, pA1, m_reg, mnA, alA);
  SLOAD(SO, KVBLK); if constexpr (SDEPTH == 2) { if (2 < NT) SLOAD(SE, 2 * KVBLK); }
  SWAIT(); SWRITE(1, SO); __syncthreads();
  for (int j = 1; j + 1 < NT; j += 2) {
    SBAR(); qkt(pB0, pB1, (bf16*)((char*)K_lds + SHM_K), qr, r32, hi);
    finishSM(pA0, pA1, alA, l_reg, pa0, pa1, pa2, pa3); SBAR();
    SLOAD(SO, (j + SDEPTH) * KVBLK); SBAR();
    pv_d0(o, vb0, pa0, pa1, pa2, pa3); partialSM(pB0, pB1, m_reg, mnB, alB);
    __syncthreads(); SWAIT(); SWRITE(0, SE);
    RESC(alB); __syncthreads();
    SBAR(); qkt(pA0, pA1, K_lds, qr, r32, hi);
    finishSM(pB0, pB1, alB, l_reg, pa0, pa1, pa2, pa3); SBAR();
    if (SDEPTH == 1 || j + 3 < NT) SLOAD(SE, (j + 1 + SDEPTH) * KVBLK); SBAR();
    pv_d0(o, vb0 + (int)SHM_V, pa0, pa1, pa2, pa3); partialSM(pA0, pA1, m_reg, mnA, alA);
    __syncthreads(); SWAIT(); SWRITE(1, SO);
    RESC(alA); __syncthreads();
  }
  SBAR(); qkt(pB0, pB1, (bf16*)((char*)K_lds + SHM_K), qr, r32, hi);
  finishSM(pA0, pA1, alA, l_reg, pa0, pa1, pa2, pa3); SBAR();
  pv_d0(o, vb0, pa0, pa1, pa2, pa3); partialSM(pB0, pB1, m_reg, mnB, alB);
  __syncthreads(); RESC(alB);
  finishSM(pB0, pB1, alB, l_reg, pa0, pa1, pa2, pa3); SBAR();
  pv_d0(o, vb0 + (int)SHM_V, pa0, pa1, pa2, pa3);
  if (hi == 0) li_l[r32] = l_reg; asm volatile("s_waitcnt lgkmcnt(0)" ::: "memory");
  float rli[16];
#pragma unroll
  for (int r = 0; r < 16; ++r) rli[r] = __builtin_amdgcn_rcpf(li_l[crow(r, hi)]);
  bf16* Ow = Ob + (long)(wid * QBLK) * LDO;
#pragma unroll
  for (int r = 0; r < 16; ++r) { int orow = crow(r, hi);
    for (int d0 = 0; d0 < 4; ++d0) ((__attribute__((address_space(1))) unsigned short*)Ow)[(long)orow * LDO + d0 * 32 + r32] = pg8::f2bf_rne(o[d0][r] * rli[r]); }
#undef SLOAD
#undef SWRITE
#undef SWAIT
#undef RESC
}
}

constexpr size_t MiB = 1u << 20;
constexpr size_t WS_MODS = 0;
constexpr size_t WS_VST  = 2 * MiB;
constexpr size_t WS_WMIX = 8 * MiB;
constexpr size_t WS_WMIX2 = 18 * MiB;
constexpr size_t WS_WGU  = 22 * MiB;
constexpr size_t WS_WDN  = 33 * MiB;
constexpr size_t WS_XCTX = 40 * MiB;
constexpr size_t WS_HMOD = 56 * MiB;
constexpr size_t WS_Z2T_CTX = WS_HMOD + 64 * MiB;
constexpr size_t WS_BIG  = 128 * MiB;
constexpr size_t WS_Q = WS_BIG, WS_K = WS_BIG + 72 * MiB, WS_V = WS_K + 18 * MiB, WS_O = WS_V + 18 * MiB;
constexpr size_t WS_PT_LAT = 272 * MiB;
constexpr size_t WS_PT_CTX = 464 * MiB;
constexpr size_t WS_EF_LAT = 488 * MiB;
constexpr size_t WS_EF_CTX = 504 * MiB;
constexpr size_t WS_SP_LAT = 506 * MiB;
constexpr size_t WS_SP_CTX = WS_SP_LAT + 65536;
constexpr size_t WS_SSQ = 507 * MiB;
constexpr size_t WS_BIAS = 509 * MiB + 512 * 1024;
constexpr size_t WS_END = 512 * MiB;
constexpr int LDS_BYTES = 155648;

#define LAS __attribute__((address_space(3)))
typedef unsigned short bf16_t;
typedef unsigned u32x4 __attribute__((ext_vector_type(4)));
typedef unsigned u32x2 __attribute__((ext_vector_type(2)));
typedef float f32x4 __attribute__((ext_vector_type(4)));
typedef float f32x2 __attribute__((ext_vector_type(2)));
typedef short bf16x8 __attribute__((ext_vector_type(8)));

__device__ __forceinline__ float bf2f(unsigned short h) { return __builtin_bit_cast(float, (unsigned)h << 16); }
__device__ __forceinline__ float bflo(unsigned w) { return __builtin_bit_cast(float, w << 16); }
__device__ __forceinline__ float bfhi(unsigned w) { return __builtin_bit_cast(float, w & 0xffff0000u); }
__device__ __forceinline__ unsigned pk2(float lo, float hi) { return pg8::cvt_pk_bf16(lo, hi); }
__device__ __forceinline__ float wave_sum(float v) {
#pragma unroll
    for (int o = 1; o < 64; o <<= 1) v += __shfl_xor(v, o);
    return v;
}

struct Args { const float* in[30]; float* out; unsigned char* ws; int ph_lo, ph_hi; };
typedef const __attribute__((address_space(4))) Args* ArgsP;
#define GAS __attribute__((address_space(1)))
__device__ __forceinline__ unsigned char* WSP(ArgsP a) { unsigned char* w = a->ws; asm volatile("" : "+s"(w)); return (unsigned char*)(GAS unsigned char*)w; }
#define AIN(i) ((const float*)(const GAS float*)(a->in[i]))
#define AOUT ((float*)(GAS float*)(a->out))
enum { I_X = 0, I_C, I_CTX, I_CCTX, I_MODW, I_MODB, I_N1G, I_N2G, I_WGU, I_WDN, I_WIN, I_LNG, I_LNB, I_WS, I_BS, I_CW, I_CB,
       I_FW1, I_FB1, I_FW2, I_FB2, I_FW3, I_FFREQ, I_SKIP, I_WOUT, I_WQKV, I_QG, I_KG, I_WO, I_FG };

__device__ __forceinline__ void gemv17_slice(f32x4 (&acc)[17], const float* W, size_t ldw, const float* cs, int kbeg) {
    const int kend = kbeg + 128;
    f32x4 r0[4], r1[4], r2[4], r3[4];
#define G17_LD(R, K0) { _Pragma("unroll") for (int i_ = 0; i_ < 4; ++i_) { const int kk_ = (K0) + i_ < kend ? (K0) + i_ : kend - 1; R[i_] = *(const f32x4*)(W + (size_t)kk_ * ldw); } }
#define G17_FMA(R, K0) { _Pragma("unroll") for (int rr_ = 0; rr_ < 17; ++rr_) { const f32x4 c4 = *(const f32x4*)(cs + rr_ * 1024 + (K0)); acc[rr_] += R[0] * c4.x + R[1] * c4.y + R[2] * c4.z + R[3] * c4.w; \
        if (rr_ % 4 == 3) __builtin_amdgcn_sched_barrier(0); } __builtin_amdgcn_sched_barrier(0); }
    G17_LD(r0, kbeg) G17_LD(r1, kbeg + 4) G17_LD(r2, kbeg + 8) G17_LD(r3, kbeg + 12)
    __builtin_amdgcn_sched_barrier(0);
#pragma unroll 1
    for (int k = kbeg; k < kend; k += 16) {
        G17_FMA(r0, k)      G17_LD(r0, k + 16) __builtin_amdgcn_sched_barrier(0);
        G17_FMA(r1, k + 4)  G17_LD(r1, k + 20) __builtin_amdgcn_sched_barrier(0);
        G17_FMA(r2, k + 8)  G17_LD(r2, k + 24) __builtin_amdgcn_sched_barrier(0);
        G17_FMA(r3, k + 12) G17_LD(r3, k + 28) __builtin_amdgcn_sched_barrier(0);
    }
#undef G17_LD
#undef G17_FMA
}

__device__ __forceinline__ void phase_mods(ArgsP a, unsigned char* lds) {
    const int tid = OTID(), lane = tid & 63, wave = tid >> 6;
    float* cs = (float*)lds;
    float* mods = (float*)(WSP(a) + WS_MODS);
    for (int unit = OBID(); unit < 96; unit += gridDim.x) {
#pragma unroll 1
        for (int h2 = 0; h2 < 2; ++h2) { float tv[17];
#pragma unroll
            for (int q = 0; q < 17; ++q) { const int i = tid + 512 * (17 * h2 + q), r = i >> 10, k = i & 1023; tv[q] = r < 16 ? ((const GAS float*)AIN(I_C))[r * 1024 + k] : ((const GAS float*)AIN(I_CCTX))[k]; }
#pragma unroll
            for (int q = 0; q < 17; ++q) cs[tid + 512 * (17 * h2 + q)] = tv[q] / (1.f + __expf(-tv[q])); }
        __syncthreads();
        const int l = unit / 24, n0 = (unit % 24) * 256;
        const float* W = AIN(I_MODW) + (size_t)l * 1024 * MODW + n0 + 4 * lane;
        f32x4 acc[17];
#pragma unroll
        for (int r = 0; r < 17; ++r) acc[r] = (f32x4){0.f, 0.f, 0.f, 0.f};
        gemv17_slice(acc, W, MODW, cs, wave * 128);
        __syncthreads();
#pragma unroll
        for (int r = 0; r < 17; ++r) *(f32x4*)(cs + ((wave * 17 + r) * 256 + 4 * lane)) = acc[r];
        __syncthreads();
        for (int i = tid; i < 17 * 256; i += 512) {
            const int r = i >> 8, cc = i & 255; float sacc = AIN(I_MODB)[l * MODW + n0 + cc];
#pragma unroll
            for (int w = 0; w < 8; ++w) sacc += cs[(w * 17 + r) * 256 + cc];
            mods[((size_t)l * 17 + r) * MODW + n0 + cc] = sacc;
        }
        __syncthreads();
    }
}

template <int MODE>
__device__ __forceinline__ void transpose_item(const float* W, int K, int N, bf16_t* WT, float* scr, int item, int lane) {
    const int nblk = N / 32, kb = item / nblk, nb = item % nblk, k0 = 64 * kb, n0 = 32 * nb;
#pragma unroll 8
    for (int i = 0; i < 32; ++i) { const int kk = 2 * i + (lane >> 5); scr[kk * 33 + (lane & 31)] = ((const GAS float*)W)[(size_t)(k0 + kk) * N + n0 + (lane & 31)]; }
    asm volatile("s_waitcnt lgkmcnt(0)" ::: "memory");
    const int c = lane & 7;
#pragma unroll
    for (int j = 0; j < 4; ++j) {
        const int n = (lane >> 3) + 8 * j; const float* s = scr + (8 * c) * 33 + n;
        u32x4 o; o.x = pk2(s[0 * 33], s[1 * 33]); o.y = pk2(s[2 * 33], s[3 * 33]); o.z = pk2(s[4 * 33], s[5 * 33]); o.w = pk2(s[6 * 33], s[7 * 33]);
        const int ng = n0 + n; const int drow = MODE == 0 ? ng : (ng < 2816 ? 2 * ng : 2 * (ng - 2816) + 1);
        *(GAS u32x4*)(WT + (size_t)drow * K + k0 + 8 * c) = o;
    }
    asm volatile("s_waitcnt lgkmcnt(0)" ::: "memory");
}
__device__ __forceinline__ void cvt_mix(ArgsP a, unsigned char* lds, int layer, int wb, int nb) {
    const int lane = OTID() & 63, wave = OTID() >> 6; float* scr = (float*)(lds + wave * 16384);
    const int gw = wb * 8 + wave, NGW = nb * 8;
    bf16_t* W1 = (bf16_t*)(WSP(a) + WS_WMIX); bf16_t* W2 = (bf16_t*)(WSP(a) + WS_WMIX2);
    if ((layer & 1) == 0) {
        const int i = layer >> 1; const float* win = AIN(I_WIN) + (size_t)i * 1024 * DIN; const float* wout = AIN(I_WOUT) + (size_t)i * 2048 * 1024;
        constexpr int I1 = (1024 / 64) * (DIN / 32), I2 = (2048 / 64) * (1024 / 32);
        for (int it = gw; it < I1 + I2; it += NGW) { if (it < I1) transpose_item<0>(win, 1024, DIN, W1, scr, it, lane); else transpose_item<0>(wout, 2048, 1024, W2, scr, it - I1, lane); }
    } else {
        const int j = layer >> 1; const float* wqkv = AIN(I_WQKV) + (size_t)j * 1024 * DQKV; const float* wo = AIN(I_WO) + (size_t)j * 1024 * 1024;
        constexpr int I1 = (1024 / 64) * (DQKV / 32), I2 = (1024 / 64) * (1024 / 32);
        for (int it = gw; it < I1 + I2; it += NGW) { if (it < I1) transpose_item<0>(wqkv, 1024, DQKV, W1, scr, it, lane); else transpose_item<0>(wo, 1024, 1024, W2, scr, it - I1, lane); }
    }
}
__device__ __forceinline__ void cvt_ffn(ArgsP a, unsigned char* lds, int layer, int wb, int nb) {
    const int lane = OTID() & 63, wave = OTID() >> 6; float* scr = (float*)(lds + wave * 16384);
    const int gw = wb * 8 + wave, NGW = nb * 8;
    const float* wgu = AIN(I_WGU) + (size_t)layer * 1024 * 2 * DFF; const float* wdn = AIN(I_WDN) + (size_t)layer * DFF * 1024;
    constexpr int I1 = (1024 / 64) * (2 * DFF / 32), I2 = (DFF / 64) * (1024 / 32);
    for (int it = gw; it < I1 + I2; it += NGW) { if (it < I1) transpose_item<1>(wgu, 1024, 2 * DFF, (bf16_t*)(WSP(a) + WS_WGU), scr, it, lane); else transpose_item<0>(wdn, DFF, 1024, (bf16_t*)(WSP(a) + WS_WDN), scr, it - I1, lane); }
}

__device__ __forceinline__ int bias_pairbase(int l) { return (l >> 1) * 17920 + (l & 1) * 10752; }
__device__ __forceinline__ int mix_n(int l) { return (l & 1) ? DQKV : DIN; }
__device__ __forceinline__ void bias_phase(ArgsP a, unsigned char* lds) {
    const int tid = OTID(), lane = tid & 63, wave = tid >> 6;
    float* cs = (float*)lds;
    const float* mods = (const float*)(WSP(a) + WS_MODS); float* bias = (float*)(WSP(a) + WS_BIAS);
    for (int unit = OBID(); unit < 140; unit += gridDim.x) {
        int l, r;
        if (unit < 42) { l = 0; r = unit; } else if (unit < 70) { l = 1; r = unit - 42; } else if (unit < 112) { l = 2; r = unit - 70; } else { l = 3; r = unit - 112; }
        const int nmixb = (l & 1) ? 6 : 20; const bool gu = r >= nmixb; const int n0 = (gu ? r - nmixb : r) * 256;
        const int N = gu ? 2 * DFF : mix_n(l);
        const float* Wb = gu ? AIN(I_WGU) + (size_t)l * 1024 * 2 * DFF : ((l & 1) ? AIN(I_WQKV) + (size_t)(l >> 1) * 1024 * DQKV : AIN(I_WIN) + (size_t)(l >> 1) * 1024 * DIN);
        const float* srcv = mods + (size_t)l * 17 * MODW + (gu ? 3072 : 0);
        float* outp = bias + (size_t)17 * (bias_pairbase(l) + (gu ? mix_n(l) : 0));
#pragma unroll 1
        for (int h2 = 0; h2 < 2; ++h2) { float tv[17];
#pragma unroll
            for (int q = 0; q < 17; ++q) { const int i = tid + 512 * (17 * h2 + q); tv[q] = ((const GAS float*)srcv)[(size_t)(i >> 10) * MODW + (i & 1023)]; }
#pragma unroll
            for (int q = 0; q < 17; ++q) cs[tid + 512 * (17 * h2 + q)] = tv[q]; }
        __syncthreads();
        const float* W = Wb + n0 + 4 * lane;
        f32x4 acc[17];
#pragma unroll
        for (int rr = 0; rr < 17; ++rr) acc[rr] = (f32x4){0.f, 0.f, 0.f, 0.f};
        gemv17_slice(acc, W, (size_t)N, cs, wave * 128);
        __syncthreads();
#pragma unroll
        for (int rr = 0; rr < 17; ++rr) *(f32x4*)(cs + ((wave * 17 + rr) * 256 + 4 * lane)) = acc[rr];
        __syncthreads();
        for (int i = tid; i < 17 * 256; i += 512) {
            const int rr = i >> 8, cc = i & 255; float sacc = 0.f;
#pragma unroll
            for (int w = 0; w < 8; ++w) sacc += cs[(w * 17 + rr) * 256 + cc];
            outp[(size_t)rr * N + n0 + cc] = sacc;
        }
        __syncthreads();
    }
}
__device__ __forceinline__ void xs_pass(ArgsP a, const float* xlat, const float* xctx, const float* g, const float* mods_l, int scoff, int wb, int nb) {
    const int lane = OTID() & 63, gw = wb * 8 + (OTID() >> 6), NGW = nb * 8;
    bf16_t* hm = (bf16_t*)(WSP(a) + WS_HMOD); float* ssq = (float*)(WSP(a) + WS_SSQ);
    for (int row0 = gw * 2; row0 < NTOK; row0 += NGW * 2) {
        f32x4 v[2][4];
#pragma unroll
        for (int q = 0; q < 2; ++q) { const int row = row0 + q; const float* xr = row < NLAT ? xlat + (size_t)row * 1024 : xctx + (size_t)(row - NLAT) * 1024;
#pragma unroll
            for (int j = 0; j < 4; ++j) v[q][j] = *(const f32x4*)(xr + 4 * lane + 256 * j); }
#pragma unroll
        for (int q = 0; q < 2; ++q) {
            const int row = row0 + q; const float* md = mods_l + (size_t)(row < NLAT ? (row >> 11) : 16) * MODW;
            float s = 0.f;
#pragma unroll
            for (int j = 0; j < 4; ++j) s += (v[q][j].x * v[q][j].x + v[q][j].y * v[q][j].y) + (v[q][j].z * v[q][j].z + v[q][j].w * v[q][j].w);
            s = wave_sum(s);
            if (lane < 16) ssq[(size_t)row * 16 + lane] = lane == 0 ? s : 0.f;
#pragma unroll
            for (int j = 0; j < 4; ++j) {
                const int c = 4 * lane + 256 * j;
                const f32x4 gg = *(const f32x4*)(g + c), sc = *(const f32x4*)(md + scoff + c);
                const f32x4 o = v[q][j] * gg * (sc + 1.f);
                u32x2 w; w.x = pk2(o.x, o.y); w.y = pk2(o.z, o.w);
                *(u32x2*)(hm + (size_t)row * 1024 + c) = w;
            }
        }
    }
}

__device__ __forceinline__ void norm_pass(ArgsP a, const float* xlat, const float* xctx, const float* g, const float* mods_l, int shoff, int scoff, int nrows) {
    const int lane = OTID() & 63, gw = OBID() * 8 + (OTID() >> 6), NGW = gridDim.x * 8;
    bf16_t* hm = (bf16_t*)(WSP(a) + WS_HMOD);
    for (int row = gw; row < nrows; row += NGW) {
        const float* xr = row < NLAT ? xlat + (size_t)row * 1024 : xctx + (size_t)(row - NLAT) * 1024;
        const float* md = mods_l + (size_t)(row < NLAT ? (row >> 11) : 16) * MODW;
        f32x4 v[4]; float s = 0.f;
#pragma unroll
        for (int j = 0; j < 4; ++j) { v[j] = *(const f32x4*)(xr + 4 * lane + 256 * j); s += (v[j].x * v[j].x + v[j].y * v[j].y) + (v[j].z * v[j].z + v[j].w * v[j].w); }
        const float rinv = rsqrtf(wave_sum(s) * (1.f / 1024.f) + 1e-6f);
#pragma unroll
        for (int j = 0; j < 4; ++j) {
            const int c = 4 * lane + 256 * j;
            const f32x4 gg = *(const f32x4*)(g + c), sc = *(const f32x4*)(md + scoff + c), sh = *(const f32x4*)(md + shoff + c);
            const f32x4 o = (v[j] * rinv) * gg * (sc + 1.f) + sh;
            u32x2 w; w.x = pk2(o.x, o.y); w.y = pk2(o.z, o.w);
            *(u32x2*)(hm + (size_t)row * 1024 + c) = w;
        }
    }
}
__device__ __forceinline__ void final_norm(ArgsP a) {
    const int lane = OTID() & 63, gw = OBID() * 8 + (OTID() >> 6), NGW = gridDim.x * 8;
    GAS float* outp = (GAS float*)a->out; const GAS float* fg = (const GAS float*)a->in[I_FG];
    for (int row0 = gw * 2; row0 < NLAT; row0 += NGW * 2) {
        f32x4 v[2][4];
#pragma unroll
        for (int q = 0; q < 2; ++q)
#pragma unroll
            for (int j = 0; j < 4; ++j) v[q][j] = *(const GAS f32x4*)(outp + (size_t)(row0 + q) * 1024 + 4 * lane + 256 * j);
#pragma unroll
        for (int q = 0; q < 2; ++q) {
            float s = 0.f;
#pragma unroll
            for (int j = 0; j < 4; ++j) s += (v[q][j].x * v[q][j].x + v[q][j].y * v[q][j].y) + (v[q][j].z * v[q][j].z + v[q][j].w * v[q][j].w);
            const float rinv = rsqrtf(wave_sum(s) * (1.f / 1024.f) + 1e-6f);
#pragma unroll
            for (int j = 0; j < 4; ++j) { const int c = 4 * lane + 256 * j; const f32x4 gg = *(const GAS f32x4*)(fg + c); *(GAS f32x4*)(outp + (size_t)(row0 + q) * 1024 + c) = (v[q][j] * rinv) * gg; }
        }
    }
}

template <int N_SEQ>
__device__ __forceinline__ void filt_out(ArgsP a, const float (&acc)[64], int colb, int chunk, int t, float tt, bool valid, int tid, int lane, int wave, float* inL, float* red) {
    const int dir = colb >> 11, order = (colb >> 10) & 1, c0 = colb & 1023;
    bf16_t* EF = (bf16_t*)(WSP(a) + (N_SEQ == 2048 ? WS_EF_LAT : WS_EF_CTX));
    float* SP = (float*)(WSP(a) + (N_SEQ == 2048 ? WS_SP_LAT : WS_SP_CTX));
    const bool use = valid && !(dir == 1 && t == 0);
    const int e = dir == 0 ? N_SEQ - t : N_SEQ + t;
    constexpr float MIN_DECAY = -3.0701134573253946f, MAX_DECAY = -15.350567286626973f;
#pragma unroll
    for (int j = 0; j < 64; ++j) {
        const int c = c0 + j;
        const float delta = fabsf(MIN_DECAY + (float)c * ((MAX_DECAY - MIN_DECAY) / 1023.f));
        const float val = acc[j] * __expf(-tt * delta);
        bf16_t* ep = EF + ((size_t)(order * 1024 + c)) * (2 * N_SEQ);
        if (use) ((GAS bf16_t*)ep)[e] = pg8::f2bf_rne(val);
        if (valid && dir == 0 && t == 0) ((GAS bf16_t*)ep)[0] = 0;
        inL[j * 512 + tid] = use ? fabsf(val) : 0.f;
    }
    __syncthreads();
    {
        float sacc = 0.f;
#pragma unroll 8
        for (int k = 0; k < 64; ++k) sacc += inL[lane * 512 + wave * 64 + ((k + lane) & 63)];
        red[wave * 64 + lane] = sacc;
    }
    __syncthreads();
    if (tid < 64) { float s = 0.f;
#pragma unroll
        for (int w = 0; w < 8; ++w) s += red[w * 64 + tid];
        SP[chunk * 4096 + colb + tid] = s; }
    __syncthreads();
}
template <int N_SEQ>
__device__ __forceinline__ void filt_unit(ArgsP a, unsigned char* lds, int li, int chunk, int cb) {
    const int tid = OTID(), lane = tid & 63, wave = tid >> 6;
    float* inL = (float*)lds; float* Wl = (float*)(lds + 131072); float* vec = (float*)(lds + 147456); float* red = (float*)(lds + 148480);
    const float* w1 = AIN(I_FW1) + (size_t)li * 33 * 64; const float* w2 = AIN(I_FW2) + (size_t)li * 64 * 64; const float* w3 = AIN(I_FW3) + (size_t)li * 64 * 4096;
    const int t = chunk * 512 + tid; const bool valid = t < N_SEQ;
    const float tt = (float)t / (float)(N_SEQ - 1);
    const float wv = (6.283185307179586f / (float)N_SEQ) * (float)t;
    inL[tid] = tt;
#pragma unroll
    for (int j = 0; j < 16; ++j) { const float band = 1e-4f + (float)j * ((15.f - 1e-4f) / 15.f); const float ang = band * wv; inL[(1 + j) * 512 + tid] = __cosf(ang); inL[(17 + j) * 512 + tid] = -__sinf(ang); }
    for (int i = tid; i < 33 * 64; i += 512) Wl[i] = w1[i];
    if (tid < 64) { vec[tid] = AIN(I_FB1)[li * 64 + tid]; vec[64 + tid] = AIN(I_FB2)[li * 64 + tid]; vec[128 + tid] = AIN(I_FFREQ)[(li * 2 + 0) * 64 + tid]; vec[192 + tid] = AIN(I_FFREQ)[(li * 2 + 1) * 64 + tid]; }
    __syncthreads();
    float acc[64];
#pragma unroll
    for (int m = 0; m < 64; ++m) acc[m] = vec[m];
    for (int k = 0; k < 33; ++k) { const float x = inL[k * 512 + tid];
#pragma unroll
        for (int m4 = 0; m4 < 16; ++m4) { const f32x4 w = *(const f32x4*)(Wl + k * 64 + 4 * m4); acc[4 * m4] += x * w.x; acc[4 * m4 + 1] += x * w.y; acc[4 * m4 + 2] += x * w.z; acc[4 * m4 + 3] += x * w.w; } }
    __syncthreads();
#pragma unroll
    for (int m = 0; m < 64; ++m) inL[m * 512 + tid] = __sinf(vec[128 + m] * acc[m]);
    for (int i = tid; i < 64 * 64; i += 512) Wl[i] = w2[i];
    __syncthreads();
#pragma unroll
    for (int m = 0; m < 64; ++m) acc[m] = vec[64 + m];
    for (int k = 0; k < 64; ++k) { const float x = inL[k * 512 + tid];
#pragma unroll
        for (int m4 = 0; m4 < 16; ++m4) { const f32x4 w = *(const f32x4*)(Wl + k * 64 + 4 * m4); acc[4 * m4] += x * w.x; acc[4 * m4 + 1] += x * w.y; acc[4 * m4 + 2] += x * w.z; acc[4 * m4 + 3] += x * w.w; } }
    __syncthreads();
#pragma unroll
    for (int m = 0; m < 64; ++m) inL[m * 512 + tid] = __sinf(vec[192 + m] * acc[m]);
    for (int i = tid; i < 64 * 64; i += 512) Wl[i] = w3[(size_t)(i >> 6) * 4096 + cb * 128 + (i & 63)];
    __syncthreads();
#pragma unroll
    for (int m = 0; m < 64; ++m) acc[m] = 0.f;
    for (int k = 0; k < 64; ++k) { const float x = inL[k * 512 + tid];
#pragma unroll
        for (int m4 = 0; m4 < 16; ++m4) { const f32x4 w = *(const f32x4*)(Wl + k * 64 + 4 * m4); acc[4 * m4] += x * w.x; acc[4 * m4 + 1] += x * w.y; acc[4 * m4 + 2] += x * w.z; acc[4 * m4 + 3] += x * w.w; } }
    __syncthreads();
    for (int i = tid; i < 64 * 64; i += 512) Wl[i] = w3[(size_t)(i >> 6) * 4096 + cb * 128 + 64 + (i & 63)];
    __syncthreads();
    float acc2[64];
#pragma unroll
    for (int m = 0; m < 64; ++m) acc2[m] = 0.f;
    for (int k = 0; k < 64; ++k) { const float x = inL[k * 512 + tid];
#pragma unroll
        for (int m4 = 0; m4 < 16; ++m4) { const f32x4 w = *(const f32x4*)(Wl + k * 64 + 4 * m4); acc2[4 * m4] += x * w.x; acc2[4 * m4 + 1] += x * w.y; acc2[4 * m4 + 2] += x * w.z; acc2[4 * m4 + 3] += x * w.w; } }
    __syncthreads();
    filt_out<N_SEQ>(a, acc, cb * 128, chunk, t, tt, valid, tid, lane, wave, inL, red);
    filt_out<N_SEQ>(a, acc2, cb * 128 + 64, chunk, t, tt, valid, tid, lane, wave, inL, red);
}
__device__ __forceinline__ void filt_phase(ArgsP a, unsigned char* lds, int li, int wb, int nb, int u_lo = 0, int u_hi = 128 + 32) {
    for (int u = u_lo + wb; u < u_hi; u += nb) {
        if (u < 128) filt_unit<2048>(a, lds, li, u >> 5, u & 31); else filt_unit<256>(a, lds, li, 0, u - 128);
    }
}

__device__ __forceinline__ void gate_unit(ArgsP a, unsigned char* lds, int li, int unit, bf16_t* dstb, int dld) {
    const int tid = OTID(), lane = tid & 63, wave = tid >> 6;
    const int g = unit & 7, ch = unit >> 3;
    const int R0 = ch < 256 ? ch * 128 : NLAT + (ch - 256) * 128;
    bf16_t* UV = (bf16_t*)(WSP(a) + WS_BIG); const float* vst = (const float*)(WSP(a) + WS_VST);
    float* st = (float*)lds; bf16_t* vnT = (bf16_t*)(lds + 1024); constexpr int VLD = 136;
    const int i16 = lane & 15, kg = lane >> 4;
    f32x4 sp[8];
    if (tid < 128) {
#pragma unroll
        for (int i = 0; i < 8; ++i) sp[i] = *(const GAS f32x4*)(vst + (size_t)(R0 + tid) * 32 + 4 * i);
    }
    const int q = tid & 127;
    u32x4 raw[4]; f32x4 lgv[4][2], lbv[4][2];
#pragma unroll
    for (int it = 0; it < 4; ++it) {
        const int cc = ((tid >> 7) * 4 + it) * 8;
        raw[it] = *(const GAS u32x4*)(UV + (size_t)(R0 + q) * 2048 + 1024 + g * 128 + cc);
        const float* lg = AIN(I_LNG) + li * 1024 + g * 128 + cc; const float* lb = AIN(I_LNB) + li * 1024 + g * 128 + cc;
        lgv[it][0] = *(const GAS f32x4*)lg; lgv[it][1] = *(const GAS f32x4*)(lg + 4); lbv[it][0] = *(const GAS f32x4*)lb; lbv[it][1] = *(const GAS f32x4*)(lb + 4);
    }
    const float* Wsp = AIN(I_WS) + ((size_t)(li * 8 + g) * 128 + wave * 16 + i16) * 128 + kg * 8;
    f32x4 wq[4][2];
#pragma unroll
    for (int ks = 0; ks < 4; ++ks) { wq[ks][0] = *(const GAS f32x4*)(Wsp + ks * 32); wq[ks][1] = *(const GAS f32x4*)(Wsp + ks * 32 + 4); }
    const f32x4 bs4 = *(const GAS f32x4*)(AIN(I_BS) + (li * 8 + g) * 128 + wave * 16 + 4 * kg);
    u32x4 uraw[4];
#pragma unroll
    for (int j = 0; j < 4; ++j) uraw[j] = *(const GAS u32x4*)(UV + (size_t)(R0 + wave * 16 + 4 * kg + j) * 2048 + g * 128 + 8 * i16);
    if (tid < 128) {
        float sacc = 0.f, qacc = 0.f;
#pragma unroll
        for (int i = 0; i < 8; ++i) { sacc += sp[i][0] + sp[i][2]; qacc += sp[i][1] + sp[i][3]; }
        const float mean = sacc * (1.f / 1024.f); const float var = qacc * (1.f / 1024.f) - mean * mean;
        st[2 * tid] = mean; st[2 * tid + 1] = rsqrtf(fmaxf(var, 0.f) + 1e-5f);
    }
    __syncthreads();
    {
        const float mean = st[2 * q], rstd = st[2 * q + 1];
#pragma unroll
        for (int it = 0; it < 4; ++it) {
            const int cc = ((tid >> 7) * 4 + it) * 8;
            const unsigned rw[4] = {raw[it].x, raw[it].y, raw[it].z, raw[it].w};
#pragma unroll
            for (int e = 0; e < 4; ++e) {
                const float g0 = lgv[it][e >> 1][(2 * e) & 3], g1 = lgv[it][e >> 1][(2 * e + 1) & 3], b0 = lbv[it][e >> 1][(2 * e) & 3], b1 = lbv[it][e >> 1][(2 * e + 1) & 3];
                const float v0 = (bflo(rw[e]) - mean) * rstd * g0 + b0, v1 = (bfhi(rw[e]) - mean) * rstd * g1 + b1;
                vnT[(cc + 2 * e) * VLD + cc + q] = pg8::f2bf_rne(v0); vnT[(cc + 2 * e + 1) * VLD + cc + q] = pg8::f2bf_rne(v1);
            }
        }
    }
    __syncthreads();
    bf16x8 af[4];
#pragma unroll
    for (int ks = 0; ks < 4; ++ks) { const f32x4 w0 = wq[ks][0], w1 = wq[ks][1];
        u32x4 w; w.x = pk2(w0.x, w0.y); w.y = pk2(w0.z, w0.w); w.z = pk2(w1.x, w1.y); w.w = pk2(w1.z, w1.w); af[ks] = __builtin_bit_cast(bf16x8, w); }
    const float bsv[4] = {bs4[0], bs4[1], bs4[2], bs4[3]};
    f32x4 acc[8];
#pragma unroll
    for (int nt = 0; nt < 8; ++nt) {
        acc[nt] = (f32x4){0.f, 0.f, 0.f, 0.f};
#pragma unroll
        for (int ks = 0; ks < 4; ++ks) { const bf16x8 bfr = *(const bf16x8*)(vnT + (i16 * 8 + nt) * VLD + i16 * 8 + ks * 32 + kg * 8);     acc[nt] = __builtin_amdgcn_mfma_f32_16x16x32_bf16(af[ks], bfr, acc[nt], 0, 0, 0); }
    }
#pragma unroll
    for (int j = 0; j < 4; ++j) {
        const unsigned uw[4] = {uraw[j].x, uraw[j].y, uraw[j].z, uraw[j].w}; u32x4 o;
        o.x = pk2(bflo(uw[0]) * (acc[0][j] + bsv[j]), bfhi(uw[0]) * (acc[1][j] + bsv[j]));
        o.y = pk2(bflo(uw[1]) * (acc[2][j] + bsv[j]), bfhi(uw[1]) * (acc[3][j] + bsv[j]));
        o.z = pk2(bflo(uw[2]) * (acc[4][j] + bsv[j]), bfhi(uw[2]) * (acc[5][j] + bsv[j]));
        o.w = pk2(bflo(uw[3]) * (acc[6][j] + bsv[j]), bfhi(uw[3]) * (acc[7][j] + bsv[j]));
        *(GAS u32x4*)(dstb + (size_t)(R0 + wave * 16 + 4 * kg + j) * dld + g * 128 + 8 * i16) = o;
    }
    __syncthreads();
}

__device__ __forceinline__ void conv8(float (&o)[8], const u32x4 raw, float prev, float next, float w0, float w1, float w2, float bb) {
    float p[10]; p[0] = prev; p[1] = bflo(raw.x); p[2] = bfhi(raw.x); p[3] = bflo(raw.y); p[4] = bfhi(raw.y); p[5] = bflo(raw.z); p[6] = bfhi(raw.z); p[7] = bflo(raw.w); p[8] = bfhi(raw.w); p[9] = next;
#pragma unroll
    for (int e = 0; e < 8; ++e) o[e] = w0 * p[e] + w1 * p[e + 1] + w2 * p[e + 2] + bb;
}
template <int N_SEQ>
__device__ __forceinline__ void toeplitz_block(f32x4 (&acc)[8], const LAS unsigned char* Zt, const LAS unsigned char* E, int t0, int lane) {
    constexpr int ZROW = N_SEQ * 2 + 16;
    const int i = lane & 15, g = lane >> 4;
    const LAS unsigned char* ep = E + (N_SEQ - t0 - 8 * i + 8 * g) * 2;
    const LAS unsigned char* zp = Zt + i * ZROW + g * 16;
#pragma unroll
    for (int r = 0; r < 8; ++r) acc[r] = (f32x4){0.f, 0.f, 0.f, 0.f};
    bf16x8 bfr = *(const LAS bf16x8*)(zp);
    u32x4 lo = *(const LAS u32x4*)(ep - 16), hi = *(const LAS u32x4*)(ep);
#pragma unroll 2
    for (int s0 = 0; s0 < N_SEQ; s0 += 32) {
        const bf16x8 bfn = *(const LAS bf16x8*)(zp + s0 * 2 + 64);
        const u32x4 lon = *(const LAS u32x4*)(ep + s0 * 2 + 48), hin = *(const LAS u32x4*)(ep + s0 * 2 + 64);
        __builtin_amdgcn_sched_barrier(0);
        const unsigned w0 = lo.x, w1 = lo.y, w2 = lo.z, w3 = lo.w, w4 = hi.x, w5 = hi.y, w6 = hi.z, w7 = hi.w;
#define TP_EVEN(r, A, B, C, D) { u32x4 f; f.x = A; f.y = B; f.z = C; f.w = D; acc[r] = __builtin_amdgcn_mfma_f32_16x16x32_bf16(__builtin_bit_cast(bf16x8, f), bfr, acc[r], 0, 0, 0); }
#define TP_ODD(r, A, B, C, D, Eh) { u32x4 f; f.x = __builtin_amdgcn_alignbit(B, A, 16); f.y = __builtin_amdgcn_alignbit(C, B, 16); f.z = __builtin_amdgcn_alignbit(D, C, 16); f.w = __builtin_amdgcn_alignbit(Eh, D, 16); \
        acc[r] = __builtin_amdgcn_mfma_f32_16x16x32_bf16(__builtin_bit_cast(bf16x8, f), bfr, acc[r], 0, 0, 0); }
        __builtin_amdgcn_s_setprio(1);
        TP_EVEN(0, w4, w5, w6, w7)
        TP_ODD(1, w3, w4, w5, w6, w7)
        TP_EVEN(2, w3, w4, w5, w6)
        TP_ODD(3, w2, w3, w4, w5, w6)
        TP_EVEN(4, w2, w3, w4, w5)
        TP_ODD(5, w1, w2, w3, w4, w5)
        TP_EVEN(6, w1, w2, w3, w4)
        TP_ODD(7, w0, w1, w2, w3, w4)
        __builtin_amdgcn_s_setprio(0);
        __builtin_amdgcn_sched_barrier(0);
        bfr = bfn; lo = lon; hi = hin;
#undef TP_EVEN
#undef TP_ODD
    }
}
struct HyX { u32x4 raw[4]; float hprev, hnext; };
template <int N_SEQ>
__device__ __forceinline__ HyX hy_load(const bf16_t* xsrc, int tt) {
    HyX h;
#pragma unroll
    for (int j = 0; j < 4; ++j) h.raw[j] = *(const GAS u32x4*)(xsrc + tt + 8 * j);
    const GAS bf16_t* xg_ = (const GAS bf16_t*)xsrc; const float p = bf2f(xg_[tt > 0 ? tt - 1 : 0]), n = bf2f(xg_[tt + 32 < N_SEQ ? tt + 32 : N_SEQ - 1]);
    h.hprev = tt > 0 ? p : 0.f; h.hnext = tt + 32 < N_SEQ ? n : 0.f;
    return h;
}
template <int N_SEQ>
__device__ __forceinline__ void hy_epi(u32x4 (&zo)[4], const f32x4 (&acc)[8], const HyX& h, const LAS unsigned char* zrow  ,
                                       int tt, float w0, float w1, float w2, float bb, float invS, float skip) {
#pragma unroll
    for (int j = 0; j < 4; ++j) {
        const float prev = j == 0 ? h.hprev : bfhi(h.raw[j == 0 ? 0 : j - 1].w), next = j == 3 ? h.hnext : bflo(h.raw[j == 3 ? 3 : j + 1].x);
        float xg[8]; conv8(xg, h.raw[j], prev, next, w0, w1, w2, bb);
        const u32x4 zi = *(const LAS u32x4*)(zrow + (tt + 8 * j) * 2);
        const float zv[8] = {bflo(zi.x), bfhi(zi.x), bflo(zi.y), bfhi(zi.y), bflo(zi.z), bfhi(zi.z), bflo(zi.w), bfhi(zi.w)};
        float o[8];
#pragma unroll
        for (int r = 0; r < 8; ++r) o[r] = xg[r] * (acc[r][j] * invS + skip * zv[r]);
        zo[j].x = pk2(o[0], o[1]); zo[j].y = pk2(o[2], o[3]); zo[j].z = pk2(o[4], o[5]); zo[j].w = pk2(o[6], o[7]);
    }
}
template <int N_SEQ, int GROUPS>
__device__ __forceinline__ void hyena_job(ArgsP a, LAS unsigned char* lds0, int li, int cbase) {
    constexpr int ZROW = N_SEQ * 2 + 16, EB = 2 * N_SEQ * 2, NTH = 512 / GROUPS, WPG = 8 / GROUPS, NPASS = (N_SEQ / 128 + WPG - 1) / WPG, GSTRIDE = ((16 * ZROW + 2 * EB + 255) / 256) * 256 + 256;
    const int tid0 = OTID(), lane = tid0 & 63, tid = tid0 % NTH, grp = tid0 / NTH, wave = (tid0 >> 6) % WPG;
    const int c = cbase * GROUPS + grp;
    LAS unsigned char* lds = lds0 + grp * GSTRIDE;
    LAS unsigned char* Zt = lds; LAS unsigned char* E0 = lds + 16 * ZROW;
    const bf16_t* PT = (const bf16_t*)(WSP(a) + (N_SEQ == 2048 ? WS_PT_LAT : WS_PT_CTX));
    const unsigned char* EF = WSP(a) + (N_SEQ == 2048 ? WS_EF_LAT : WS_EF_CTX);
    const float* SP = (const float*)(WSP(a) + (N_SEQ == 2048 ? WS_SP_LAT : WS_SP_CTX));
    bf16_t* Z2 = (bf16_t*)(WSP(a) + (N_SEQ == 2048 ? WS_HMOD : WS_Z2T_CTX));
    for (int i = tid; i < 2 * EB / 16; i += NTH) { const int order = i / (EB / 16), off = i % (EB / 16);
        *(LAS u32x4*)(E0 + order * EB + off * 16) = *(const GAS u32x4*)(EF + (size_t)(order * 1024 + c) * EB + off * 16); }
    const float* cw = AIN(I_CW) + (size_t)li * 3 * 3072; const float* cbv = AIN(I_CB) + (size_t)li * 3072;
    {
        const float w0 = cw[c], w1 = cw[3072 + c], w2 = cw[2 * 3072 + c], bb = cbv[c];
        constexpr int NCH = (16 * N_SEQ / 8 + NTH - 1) / NTH;
        u32x4 raw[NCH]; unsigned short hp[NCH], hn[NCH];
#pragma unroll
        for (int q = 0; q < NCH; ++q) {
            const int ch = tid + NTH * q; const int b = ch / (N_SEQ / 8), tq = (ch % (N_SEQ / 8)) * 8;
            const bf16_t* src = PT + ((size_t)(b * 3072 + c)) * N_SEQ;
            const GAS bf16_t* sg_ = (const GAS bf16_t*)src; raw[q] = *(const GAS u32x4*)(src + tq); hp[q] = sg_[tq > 0 ? tq - 1 : 0]; hn[q] = sg_[tq + 8 < N_SEQ ? tq + 8 : N_SEQ - 1];
        }
#pragma unroll
        for (int q = 0; q < NCH; ++q) {
            const int ch = tid + NTH * q; const int b = ch / (N_SEQ / 8), tq = (ch % (N_SEQ / 8)) * 8;
            const float prev = tq > 0 ? bf2f(hp[q]) : 0.f, next = tq + 8 < N_SEQ ? bf2f(hn[q]) : 0.f;
            float o[8]; conv8(o, raw[q], prev, next, w0, w1, w2, bb);
            u32x4 w; w.x = pk2(o[0], o[1]); w.y = pk2(o[2], o[3]); w.z = pk2(o[4], o[5]); w.w = pk2(o[6], o[7]);
            *(LAS u32x4*)(Zt + b * ZROW + tq * 2) = w;
        }
    }
    float invS[2];
#pragma unroll
    for (int o = 0; o < 2; ++o) { float s = 0.f;
        for (int chn = 0; chn < (N_SEQ == 2048 ? 4 : 1); ++chn) s += ((const GAS float*)SP)[chn * 4096 + o * 1024 + c] + ((const GAS float*)SP)[chn * 4096 + 2048 + o * 1024 + c];
        invS[o] = 1.f / s; }
    const float skip0 = AIN(I_SKIP)[(li * 2 + 0) * 1024 + c], skip1 = AIN(I_SKIP)[(li * 2 + 1) * 1024 + c];
    __syncthreads();
    const int b = lane & 15, g = lane >> 4;
    const LAS unsigned char* zrow = Zt + b * ZROW;
    u32x4 z1p[NPASS][4];
    {
        const int col = 1024 + c; const float w0 = cw[col], w1 = cw[3072 + col], w2 = cw[2 * 3072 + col], bb = cbv[col];
        const bf16_t* xsrc = PT + ((size_t)(b * 3072 + col)) * N_SEQ;
#pragma unroll
        for (int ps = 0; ps < NPASS; ++ps) {
            const int t0 = (wave + WPG * ps) * 128;
            if (t0 < N_SEQ) { const HyX hx = hy_load<N_SEQ>(xsrc, t0 + 32 * g); f32x4 acc[8]; toeplitz_block<N_SEQ>(acc, Zt, E0, t0, lane); hy_epi<N_SEQ>(z1p[ps], acc, hx, zrow, t0 + 32 * g, w0, w1, w2, bb, invS[0], skip0); }
        }
    }
    __syncthreads();
#pragma unroll
    for (int ps = 0; ps < NPASS; ++ps) { const int t0 = (wave + WPG * ps) * 128;
        if (t0 < N_SEQ) {
#pragma unroll
            for (int j = 0; j < 4; ++j) *(LAS u32x4*)(Zt + b * ZROW + (t0 + 32 * g + 8 * j) * 2) = z1p[ps][j]; } }
    __syncthreads();
    {
        const int col = 2048 + c; const float w0 = cw[col], w1 = cw[3072 + col], w2 = cw[2 * 3072 + col], bb = cbv[col];
        const bf16_t* xsrc = PT + ((size_t)(b * 3072 + col)) * N_SEQ;
        bf16_t* zdst = Z2 + ((size_t)(b * 1024 + c)) * N_SEQ;
#pragma unroll
        for (int ps = 0; ps < NPASS; ++ps) {
            const int t0 = (wave + WPG * ps) * 128;
            if (t0 < N_SEQ) { const HyX hx = hy_load<N_SEQ>(xsrc, t0 + 32 * g); f32x4 acc[8]; toeplitz_block<N_SEQ>(acc, Zt, E0 + EB, t0, lane); u32x4 zo[4]; hy_epi<N_SEQ>(zo, acc, hx, zrow, t0 + 32 * g, w0, w1, w2, bb, invS[1], skip1);
#pragma unroll
                for (int j = 0; j < 4; ++j) *(GAS u32x4*)(zdst + t0 + 32 * g + 8 * j) = zo[j]; }
        }
    }
    __syncthreads();
}

__device__ __forceinline__ void z2_transpose(ArgsP a, unsigned char* lds) {
    const int lane = OTID() & 63, wave = OTID() >> 6, gw = OBID() * 8 + wave, NGW = gridDim.x * 8;
    unsigned* tl = (unsigned*)(lds + wave * 8704);
    bf16_t* cat = (bf16_t*)(WSP(a) + WS_BIG);
    constexpr int NT_LAT = 16 * 16 * 32, NT_CTX = 16 * 16 * 4;
    for (int it = gw; it < NT_LAT + NT_CTX; it += NGW) {
        int b, cbk, tbk, nseq; const bf16_t* src; size_t rowbase;
        if (it < NT_LAT) { b = it / (16 * 32); cbk = (it / 32) % 16; tbk = it % 32; nseq = 2048; src = (const bf16_t*)(WSP(a) + WS_HMOD); rowbase = (size_t)b * 2048; }
        else { const int i2 = it - NT_LAT; b = i2 / (16 * 4); cbk = (i2 / 4) % 16; tbk = i2 % 4; nseq = 256; src = (const bf16_t*)(WSP(a) + WS_Z2T_CTX); rowbase = (size_t)NLAT + (size_t)b * 256; }
        const bf16_t* sp = src + ((size_t)(b * 1024 + cbk * 64)) * nseq + tbk * 64;
#pragma unroll
        for (int i = 0; i < 8; ++i) { const int cr = 8 * i + (lane >> 3), chk = lane & 7; const u32x4 v = *(const GAS u32x4*)(sp + (size_t)cr * nseq + chk * 8);
            unsigned* d = tl + cr * 33 + chk * 4; d[0] = v.x; d[1] = v.y; d[2] = v.z; d[3] = v.w; }
        asm volatile("s_waitcnt lgkmcnt(0)" ::: "memory");
        const unsigned short* ts = (const unsigned short*)tl;
#pragma unroll
        for (int i = 0; i < 8; ++i) { const int tr = 8 * i + (lane >> 3), chk = lane & 7;
            unsigned short e[8];
#pragma unroll
            for (int k = 0; k < 8; ++k) e[k] = ts[(chk * 8 + k) * 66 + tr];
            u32x4 w; w.x = e[0] | ((unsigned)e[1] << 16); w.y = e[2] | ((unsigned)e[3] << 16); w.z = e[4] | ((unsigned)e[5] << 16); w.w = e[6] | ((unsigned)e[7] << 16);
            *(GAS u32x4*)(cat + (rowbase + tbk * 64 + tr) * 2048 + 1024 + cbk * 64 + chk * 8) = w; }
        asm volatile("s_waitcnt lgkmcnt(0)" ::: "memory");
    }
}

__device__ __forceinline__ void qk_prep(ArgsP a, int j) {
    const int lane = OTID() & 63, gw = OBID() * 8 + (OTID() >> 6), NGW = gridDim.x * 8;
    bf16_t* Kb = (bf16_t*)(WSP(a) + WS_K);
    const int d0 = 2 * lane;
    const f32x2 kg = *(const f32x2*)(AIN(I_KG) + j * 128 + d0);
    const int i0 = d0 & 63;
    const float inv0 = exp2f(-(float)(i0 & 31) * (13.287712379549449f / 32.f)), inv1 = exp2f(-(float)((i0 + 1) & 31) * (13.287712379549449f / 32.f));
    const bool second = lane >= 32;
    for (int tok0 = gw * 4; tok0 < NTOK; tok0 += NGW * 4) {
        unsigned raw[4][2]; unsigned* kp[4];
#pragma unroll
        for (int q = 0; q < 4; ++q) { const int tok = tok0 + q;
            const int kvrow = tok < NLAT ? (tok >> 11) * SKV + CTXL + (tok & 2047) : ((tok - NLAT) >> 8) * SKV + ((tok - NLAT) & 255);
            kp[q] = (unsigned*)(Kb + (size_t)kvrow * 256) + lane; raw[q][0] = kp[q][0]; raw[q][1] = kp[q][64]; }
#pragma unroll
        for (int q = 0; q < 4; ++q) { const int tok = tok0 + q;
            float cs0 = 1.f, sn0 = 0.f, cs1 = 1.f, sn1 = 0.f;
            if (tok < NLAT) { const int t = tok & 2047; const float pos = (i0 < 32) ? (float)(t >> 6) : (float)(t & 63);
                cs0 = __cosf(pos * inv0); sn0 = __sinf(pos * inv0); cs1 = __cosf(pos * inv1); sn1 = __sinf(pos * inv1); }
            if (!second) { sn0 = -sn0; sn1 = -sn1; }
#pragma unroll
            for (int h = 0; h < 2; ++h) {
                float v0 = bflo(raw[q][h]), v1 = bfhi(raw[q][h]);
                const float rinv = rsqrtf(wave_sum(v0 * v0 + v1 * v1) * (1.f / 128.f) + 1e-6f);
                v0 *= rinv * kg.x; v1 *= rinv * kg.y;
                const float p0 = __shfl_xor(v0, 32), p1 = __shfl_xor(v1, 32);
                kp[q][h * 64] = pk2(v0 * cs0 + p0 * sn0, v1 * cs1 + p1 * sn1);
            }
        }
    }
}

#define RLX_AGENT __ATOMIC_RELAXED, __HIP_MEMORY_SCOPE_AGENT
constexpr size_t WS_BAR = 0x1D0000;
#define XB_TMO      128
#define XB_XCNT(j)  (256  + 64 * (j))
#define XB_XSUB(j)  (1280 + 64 * (j))
#define XB_XGEN(j)  (2304 + 64 * (j))
#define XB_TOP      3328
#define XB_TOPGEN   3392
#define XCD_BAR_WORDS 3456
#define XB_SPIN_CAP (1u << 18)

__device__ __forceinline__ unsigned xb_ld(unsigned* p)              { return __hip_atomic_load(p, __ATOMIC_RELAXED, __HIP_MEMORY_SCOPE_AGENT); }
__device__ __forceinline__ unsigned xb_add(unsigned* p, unsigned v) { return __hip_atomic_fetch_add(p, v, __ATOMIC_RELAXED, __HIP_MEMORY_SCOPE_AGENT); }
__device__ __forceinline__ unsigned xb_xcc_id() { return (unsigned)__builtin_amdgcn_s_getreg((3 << 11) | 20) & 0xFu; }
#define XB_SPIN(cond, bar) do { unsigned _sp = 0; while (cond) { __builtin_amdgcn_s_sleep(1); \
    if ((++_sp & 255u) == 0u) { if (xb_ld(&(bar)[XB_TMO])) break; if (_sp > XB_SPIN_CAP) { atomicAdd(&(bar)[XB_TMO], 1u); break; } } } } while (0)

struct XcdBarrier {
    unsigned* bar; unsigned x;
    volatile LAS unsigned* st;
};

__device__ __forceinline__ XcdBarrier xcd_barrier_post(unsigned* bar, volatile LAS unsigned* st) {
    XcdBarrier b; b.bar = bar; b.x = xb_xcc_id(); b.st = st;
    if (threadIdx.x == 0) (void)xb_add(&bar[XB_XCNT(b.x)], 1u);
    return b;
}
__device__ __forceinline__ void xcd_barrier_complete(unsigned* bar, unsigned x, unsigned& nloc, unsigned& nx) {
    const unsigned G = gridDim.x * gridDim.y * gridDim.z;
    unsigned sum, cnt, mine, sp = 0u;
    for (;;) {
        sum = 0u; cnt = 0u; mine = 0u;
#pragma unroll
        for (unsigned j = 0; j < 16; ++j) { const unsigned c = xb_ld(&bar[XB_XCNT(j)]); sum += c; cnt += (c > 0u) ? 1u : 0u; mine = (j == x) ? c : mine; }
        if (sum == G) break;
        __builtin_amdgcn_s_sleep(1);
        if ((++sp & 255u) == 0u) { if (xb_ld(&bar[XB_TMO])) break; if (sp > XB_SPIN_CAP) { atomicAdd(&bar[XB_TMO], 1u); break; } }
    }
    nloc = mine > 0u ? mine : 1u; nx = cnt > 0u ? cnt : 1u;
}

__device__ __forceinline__ void xcd_barrier(const XcdBarrier& b) {
    asm volatile("s_waitcnt vmcnt(0)" ::: "memory");
    __syncthreads();
    if (threadIdx.x == 0) {
        unsigned* bar = b.bar;
        __builtin_amdgcn_s_waitcnt(0);
        unsigned nloc = b.st[0], nx = b.st[1];
        if (nloc == 0u) { xcd_barrier_complete(bar, b.x, nloc, nx); b.st[0] = nloc; b.st[1] = nx; }
        const unsigned old = xb_add(&bar[XB_XSUB(b.x)], 1u);
        const unsigned gen = old / nloc;
        if (old + 1u == (gen + 1u) * nloc) {
            __builtin_amdgcn_fence(__ATOMIC_RELEASE, "agent");
            asm volatile("s_waitcnt vmcnt(0)" ::: "memory");
            const unsigned og = xb_add(&bar[XB_TOP], 1u);
            const unsigned tg = og / nx;
            if (og + 1u == (tg + 1u) * nx) xb_add(&bar[XB_TOPGEN], 1u);
            else XB_SPIN(xb_ld(&bar[XB_TOPGEN]) == tg, bar);
            __builtin_amdgcn_fence(__ATOMIC_ACQUIRE, "agent");
            xb_add(&bar[XB_XGEN(b.x)], 1u);
            asm volatile("s_waitcnt vmcnt(0)" ::: "memory");
        } else {
            XB_SPIN(xb_ld(&bar[XB_XGEN(b.x)]) == gen, bar);
            __builtin_amdgcn_fence(__ATOMIC_ACQUIRE, "agent");
            asm volatile("s_waitcnt vmcnt(0)" ::: "memory");
        }
    }
    __syncthreads();
}

struct LayerCtx { const float* mods_l; const float* xin_lat; const float* xin_ctx; float* xctx; bf16_t* hmod; float* dum_lat; float* dum_ctx; int Mres; bool last; };
__device__ __forceinline__ LayerCtx mk_ctx(ArgsP a, int l) {
    LayerCtx c; unsigned char* ws = WSP(a);
    c.mods_l = (const float*)(ws + WS_MODS) + (size_t)l * 17 * MODW;
    c.xctx = (float*)(ws + WS_XCTX); c.hmod = (bf16_t*)(ws + WS_HMOD);
    c.xin_lat = l == 0 ? AIN(I_X) : AOUT; c.xin_ctx = l == 0 ? AIN(I_CTX) : c.xctx;
    c.dum_lat = (float*)(ws + 328 * MiB); c.dum_ctx = (float*)(ws + 456 * MiB);
    c.last = l == 3; c.Mres = c.last ? NLAT : NTOK;
    return c;
}
#ifndef DUPMASK
#define DUPMASK 0
#endif
__global__ void __launch_bounds__(512, 2) mega_fwd(Args kargs) {
    extern __shared__ __attribute__((aligned(16))) unsigned char lds[];
    cg::grid_group grid = cg::this_grid();
    ArgsP a0 = (ArgsP)__builtin_amdgcn_kernarg_segment_ptr();
    int ph = 0;
    const int lo = kargs.ph_lo, hi = kargs.ph_hi;
    volatile LAS unsigned* bst = (volatile LAS unsigned*)((LAS unsigned char*)lds + (LDS_BYTES - 16));
    if (threadIdx.x == 0) { bst[0] = 0u; bst[1] = 0u; }
    __syncthreads();
    const XcdBarrier xbar = xcd_barrier_post((unsigned*)(kargs.ws + WS_BAR), bst);
    if (lo < 0) grid.sync();
#define PH_BEGIN(bit) if (ph >= lo && ph < hi) { ArgsP a = a0; asm volatile("" : "+s"(a)); int L = l; asm volatile("" : "+s"(L)); const LayerCtx c = mk_ctx(a, L); \
        LAS unsigned char* ldsl = (LAS unsigned char*)lds; const int G = gridDim.x, bx = OBID(); (void)c; (void)ldsl; (void)G; (void)bx; \
        for (int rep = ((DUPMASK >> (bit)) & 1) ? 0 : 1; rep < 2; ++rep) {
#define PH_END   if (ph + 1 < hi || rep == 0) xcd_barrier(xbar); } } ++ph;

    int l = 0;
    PH_BEGIN(11)
        if (bx < 96 || G < 192) phase_mods(a, lds);
        { const bool sp = G >= 192; const int wb = sp ? bx - 96 : bx, nb = sp ? G - 96 : G; if (wb >= 0) { __syncthreads(); cvt_mix(a, lds, 0, wb, nb); __syncthreads(); filt_phase(a, lds, 0, wb, nb); } }
    PH_END

    PH_BEGIN(0)
        bias_phase(a, lds);
        if (G > 140) {
            const int nvw = 140 + 3 * (G - 140);
            if (bx < 140) xs_pass(a, AIN(I_X), AIN(I_CTX), AIN(I_N1G), c.mods_l, 1024, bx, nvw);
            else for (int q = 0; q < 3; ++q) xs_pass(a, AIN(I_X), AIN(I_CTX), AIN(I_N1G), c.mods_l, 1024, 140 + 3 * (bx - 140) + q, nvw);
        } else xs_pass(a, AIN(I_X), AIN(I_CTX), AIN(I_N1G), c.mods_l, 1024, bx, G);
    PH_END
#pragma unroll 1
    for (l = 0; l < 4; ++l) {
        if ((l & 1) == 0) {
            PH_BEGIN(2)
                pg8::Gemm gm{c.hmod, (const bf16_t*)(WSP(a) + WS_WMIX), NTOK, DIN, 1024}; pg8::StaticOrder S; S.init(NTOK, DIN, G, bx);
                pg8::EpiE1 E{(bf16_t*)(WSP(a) + WS_BIG), (float*)(WSP(a) + WS_VST), (bf16_t*)(WSP(a) + WS_PT_LAT), (bf16_t*)(WSP(a) + WS_PT_CTX), (const float*)(WSP(a) + WS_SSQ), (const float*)(WSP(a) + WS_BIAS) + (size_t)17 * bias_pairbase(L)};
                pg8::gemm_phase<pg8::EpiE1, pg8::StaticOrder, true, true>(ldsl, gm, S, E);
            PH_END
            PH_BEGIN(3)
                const int li = L >> 1;
                if (rep == 1) { for (int ch = bx; ch < 1024; ch += G) hyena_job<2048, 1>(a, ldsl, li, ch);
                    for (int ch = bx; ch < 256; ch += G) hyena_job<256, 4>(a, ldsl, li, ch); }
                for (int u = bx; u < 288 * 8; u += G) gate_unit(a, lds, li, u, rep == 1 ? (bf16_t*)(WSP(a) + WS_BIG) : c.hmod, rep == 1 ? 2048 : 1024);
            PH_END
            PH_BEGIN(4)
                z2_transpose(a, lds);
            PH_END
        } else {
            PH_BEGIN(6)
                pg8::Gemm gm{c.hmod, (const bf16_t*)(WSP(a) + WS_WMIX), NTOK, DQKV, 1024}; pg8::StaticOrder S; S.init(NTOK, DQKV, G, bx);
                pg8::EpiQKV E{(bf16_t*)(WSP(a) + WS_Q), (bf16_t*)(WSP(a) + WS_K), (bf16_t*)(WSP(a) + WS_V), (const float*)(WSP(a) + WS_SSQ), (const float*)(WSP(a) + WS_BIAS) + (size_t)17 * bias_pairbase(L)};
                pg8::gemm_phase<pg8::EpiQKV, pg8::StaticOrder, true, true>(ldsl, gm, S, E);
            PH_END
            PH_BEGIN(7)
                qk_prep(a, L >> 1);
            PH_END
            PH_BEGIN(8)
                const att::bf16* Q = (const att::bf16*)(WSP(a) + WS_Q); const att::bf16* Kb = (const att::bf16*)(WSP(a) + WS_K); const att::bf16* Vb = (const att::bf16*)(WSP(a) + WS_V); att::bf16* O = (att::bf16*)(WSP(a) + WS_O);
                const int nun = c.last ? 1024 : 1024 + 128;
                const int vbx = (G % 8 == 0) ? (bx % 8) * (G / 8) + bx / 8 : bx;
                for (int u = vbx; u < nun; u += G) {
                    const bool isl = u < 1024; const int v = u - 1024;
                    const int h = isl ? (u >> 3) & 7 : v & 7, b = isl ? u >> 6 : v >> 3;
                    const size_t r0 = isl ? (size_t)b * 2048 + (u & 7) * 256 : (size_t)NLAT + (size_t)b * 256;
                    const size_t kv0 = (size_t)b * SKV * 256 + (h >> 2) * 128;
                    att::attn_dense_body<att::bf16>(Q + r0 * 1024 + h * 128, Kb + kv0, Vb + kv0, O + r0 * 1024 + h * 128, isl ? SKV : CTXL, (char*)lds, AIN(I_QG) + (L >> 1) * 128, isl ? (u & 7) * 256 : -1);
                    __syncthreads();
                }
            PH_END
        }
        PH_BEGIN(5)
            const bool ev = (L & 1) == 0;
            pg8::Gemm gm{(const bf16_t*)(WSP(a) + (ev ? WS_BIG : WS_O)), (const bf16_t*)(WSP(a) + WS_WMIX2), c.Mres, 1024, ev ? 2048 : 1024}; pg8::StaticOrder S; S.init(c.Mres, 1024, G, bx);
            pg8::EpiRes E{c.xin_lat, c.xin_ctx, rep == 0 ? c.dum_lat : AOUT, rep == 0 ? c.dum_ctx : c.xctx, c.mods_l + 2048, AIN(I_N2G) + L * 1024, c.mods_l + 4096, c.hmod, (float*)(WSP(a) + WS_SSQ)};
            pg8::gemm_phase<pg8::EpiRes, pg8::StaticOrder, true, true>(ldsl, gm, S, E);
            if (rep == 1) { const int rem = ((c.Mres / 256) * 4) % G, wb = rem ? bx - rem : bx, nb = rem ? G - rem : G;
                if (wb >= 0) { __syncthreads(); cvt_ffn(a, lds, L, wb, nb); } }
        PH_END
        PH_BEGIN(9)
            pg8::Gemm gm{c.hmod, (const bf16_t*)(WSP(a) + WS_WGU), c.Mres, 2 * DFF, 1024}; pg8::StaticOrder S; S.init(c.Mres, 2 * DFF, G, bx);
            pg8::EpiSwiGLU E{(bf16_t*)(WSP(a) + WS_BIG), (const float*)(WSP(a) + WS_SSQ), (const float*)(WSP(a) + WS_BIAS) + (size_t)17 * (bias_pairbase(L) + mix_n(L))};
            pg8::gemm_phase<pg8::EpiSwiGLU, pg8::StaticOrder, true, true>(ldsl, gm, S, E);
        PH_END
        PH_BEGIN(10)
            pg8::Gemm gm{(const bf16_t*)(WSP(a) + WS_BIG), (const bf16_t*)(WSP(a) + WS_WDN), c.Mres, 1024, DFF}; pg8::StaticOrder S; S.init(c.Mres, 1024, G, bx);
            pg8::EpiRes E{AOUT, c.xctx, rep == 0 ? c.dum_lat : AOUT, rep == 0 ? c.dum_ctx : c.xctx, c.mods_l + 5120, c.last ? (const float*)nullptr : AIN(I_N1G) + (L + 1) * 1024, c.mods_l + 17 * MODW + 1024, c.hmod, (float*)(WSP(a) + WS_SSQ)};
            pg8::gemm_phase<pg8::EpiRes, pg8::StaticOrder, true, true>(ldsl, gm, S, E);
            if (rep == 1 && !c.last) { const int rem = ((c.Mres / 256) * 4) % G, wb = rem ? bx - rem : bx, nb = rem ? G - rem : G;
                if (wb >= 0) { __syncthreads(); cvt_mix(a, lds, L + 1, wb, nb); if (L < 2) { __syncthreads(); filt_phase(a, lds, 1, wb, nb, L == 0 ? 0 : 80, L == 0 ? 80 : 160); } } }
        PH_END
    }
    PH_BEGIN(12)
        final_norm(a);
    PH_END
#undef PH_BEGIN
#undef PH_END
}
constexpr int N_PHASES = 2 + 4 * 6 + 1;

extern "C" void kernel_launch(void* const* d_in, const int* in_sizes, int n_in, void* d_out, int out_size, void* d_ws, size_t ws_size, hipStream_t stream) {
    static int grid = 0;
    if (grid == 0) {
        if (n_in != 30 || out_size != NLAT * DM || ws_size < WS_END) { fprintf(stderr, "kernel_launch: unexpected shapes: n_in %d out %d ws %zu (need %zu)\n", n_in, out_size, ws_size, (size_t)WS_END); grid = -1; return; }
        int dev = 0, cus = 0, per_cu = 0;
        hipGetDevice(&dev); hipDeviceGetAttribute(&cus, hipDeviceAttributeMultiprocessorCount, dev);
        if (hipFuncSetAttribute((const void*)mega_fwd, hipFuncAttributeMaxDynamicSharedMemorySize, LDS_BYTES) != hipSuccess) { fprintf(stderr, "kernel_launch: hipFuncSetAttribute failed\n"); grid = -1; return; }
        if (hipOccupancyMaxActiveBlocksPerMultiprocessor(&per_cu, (const void*)mega_fwd, 512, LDS_BYTES) != hipSuccess || per_cu < 1) { fprintf(stderr, "kernel_launch: occupancy query says %d\n", per_cu); per_cu = 1; }
        (void)hipGetLastError();
        grid = cus * 1;
        fprintf(stderr, "kernel_launch: cus %d per_cu %d grid %d ws %zu\n", cus, per_cu, grid, ws_size);
    }
    if (grid < 0) return;
    Args a{};
    for (int i = 0; i < 30; ++i) a.in[i] = (const float*)d_in[i];
    a.out = (float*)d_out; a.ws = (unsigned char*)d_ws; a.ph_lo = 0; a.ph_hi = N_PHASES;
    if (hipMemsetAsync((char*)d_ws + WS_BAR, 0, 16384, stream) != hipSuccess) { fprintf(stderr, "kernel_launch: memset failed\n"); return; }
    void* args[] = {&a};
    hipError_t e = hipLaunchCooperativeKernel((const void*)mega_fwd, dim3(grid), dim3(512), args, LDS_BYTES, stream);
    if (e != hipSuccess) fprintf(stderr, "kernel_launch: cooperative launch failed: %s\n", hipGetErrorString(e));
}
```

```cpp
#include <hip/hip_runtime.h>
#include <hip/hip_cooperative_groups.h>
#include <hip/hip_bf16.h>
#include <cstdio>
#include <cstdint>
namespace cg = cooperative_groups;

constexpr int DM = 1024, NB = 16, SEQ = 2048, CTXL = 256;
constexpr int NLAT = NB * SEQ, NCTX = NB * CTXL, NTOK = NLAT + NCTX;
constexpr int DFF = 2816, DIN = 5120, DQKV = 1536, SKV = CTXL + SEQ;
constexpr int MODW = 6 * DM;

__device__ __forceinline__ int OTID() { int t = threadIdx.x; asm volatile("" : "+v"(t)); return t; }
__device__ __forceinline__ int OBID() { int t = blockIdx.x; asm volatile("" : "+s"(t)); return t; }

namespace pg8 {
#define PG8_LAS __attribute__((address_space(3)))
typedef unsigned short bf16_t;
typedef short bf16x8 __attribute__((ext_vector_type(8)));
typedef float f32x4 __attribute__((ext_vector_type(4)));
typedef unsigned u32x4 __attribute__((ext_vector_type(4)));
constexpr int BM = 256, BK = 64, HALF = 128, HTB = HALF * BK * 2  , STAGE_BYTES = 8 * HTB, NXCD = 8, WGM = 4;

__host__ __device__ __forceinline__ int lds_byte(int r, int c) { const int st = (r >> 4) * 2 + (c >> 5), rr = r & 15, cc = c & 31, ob = rr * 64 + cc * 2; return st * 1024 + (ob ^ (((ob >> 9) & 1) << 5)); }
__host__ __device__ __forceinline__ void stage_rc(int b, int& R, int& C) { const int st = b / 1024, sb = b % 1024, swz = sb ^ (((sb >> 9) & 1) << 5); R = (st >> 1) * 16 + swz / 64; C = (st & 1) * 32 + (swz % 64) / 2; }
__host__ __device__ __forceinline__ int perm32(int rho) { const int n = rho >> 4, i = rho & 15; return 8 * (i >> 2) + 4 * n + (i & 3); }

struct Unit { int pm, pn; };
struct Gemm { const bf16_t* A; const bf16_t* Bt; int M, N, K; };

struct StaticOrder {
    int nM, nN, nwg, G, c;
    __host__ __device__ __forceinline__ void init(int M, int N, int G_, int c_) { nM = M / BM; nN = N / BM; nwg = nM * nN; G = G_; c = c_; }
    __host__ __device__ __forceinline__ bool next(int i, Unit& u) const {
        const long L = (long)i * G + c; if (L >= nwg) return false;
        int wgid = (int)L; { const int q = nwg / NXCD, r = nwg % NXCD, xcd = wgid % NXCD, off = wgid / NXCD; wgid = (xcd < r ? xcd * (q + 1) : r * (q + 1) + (xcd - r) * q) + off; }
        const int nig = WGM * nN, gid = wgid / nig, fm = gid * WGM, gsz = (nM - fm) < WGM ? (nM - fm) : WGM;
        u.pm = fm + ((wgid % nig) % gsz); u.pn = (wgid % nig) / gsz; return true;
    }
    __device__ __forceinline__ void a_ready(const Unit&) const {}
    __device__ __forceinline__ void done(const Unit&) const {}
};

__device__ __forceinline__ unsigned cvt_pk_bf16(float lo, float hi) { unsigned r; asm volatile("v_cvt_pk_bf16_f32 %0, %1, %2" : "=v"(r) : "v"(lo), "v"(hi)); return r; }
typedef float f32x2 __attribute__((ext_vector_type(2)));
__device__ __forceinline__ f32x2 gelu_pk(f32x2 v) {
    const f32x2 av = __builtin_elementwise_abs(v), d = av * 0.2316418882f + 1.0f;
    f32x2 t; t.x = __builtin_amdgcn_rcpf(d.x); t.y = __builtin_amdgcn_rcpf(d.y);
    f32x2 q = t * 0.5307027145f + (-0.7265760135f); q = q * t + 0.7107068705f; q = q * t + (-0.142248368f); q = q * t + 0.127414796f; q = q * t;
    const f32x2 s = (v * v) * (-0.72134752044f);
    f32x2 e; e.x = __builtin_amdgcn_exp2f(s.x); e.y = __builtin_amdgcn_exp2f(s.y);
    const f32x2 m = v * (q * e), r = v - m;
    f32x2 o; o.x = v.x < 0.f ? m.x : r.x; o.y = v.y < 0.f ? m.y : r.y; return o;
}
#define PG8_GAS __attribute__((address_space(1)))
__device__ __forceinline__ unsigned short f2bf_rne(float f) { unsigned u = __builtin_bit_cast(unsigned, f); return (unsigned short)((u + 0x7fffu + ((u >> 16) & 1u)) >> 16); }

__device__ __forceinline__ void rows_rinv(float (&rinv)[2][4], const float* ssq, int row0  , int fq) {
    f32x4 p[2][4];
#pragma unroll
    for (int ai = 0; ai < 2; ++ai)
#pragma unroll
        for (int m = 0; m < 4; ++m) p[ai][m] = *(const PG8_GAS f32x4*)(ssq + (size_t)(row0 + ai * HALF + m * 16) * 16 + 4 * fq);
#pragma unroll
    for (int ai = 0; ai < 2; ++ai)
#pragma unroll
        for (int m = 0; m < 4; ++m) { float s = (p[ai][m][0] + p[ai][m][1]) + (p[ai][m][2] + p[ai][m][3]); s += __shfl_xor(s, 16); s += __shfl_xor(s, 32); rinv[ai][m] = rsqrtf(s * (1.f / 1024.f) + 1e-6f); }
}
struct EpiE1 {
    static constexpr bool PERM = true, AFTER_DRAIN = false;
    bf16_t* UV; float* vst; bf16_t* pt_lat; bf16_t* pt_ctx; const float* ssq; const float* bias;
    __device__ __forceinline__ void operator()(const f32x4 (&acc)[2][2][4][2], const Unit& u, int wr, int wc, int fr_, int fq) const {
        int fr = fr_; asm volatile("" : "+v"(fr));
        const float* bp = bias + (size_t)(u.pm < 128 ? (u.pm >> 3) : 16) * 5120 + u.pn * BM + wc * 32 + 8 * fq;
        f32x4 bv[2][2];
#pragma unroll
        for (int bj = 0; bj < 2; ++bj)
#pragma unroll
            for (int n = 0; n < 2; ++n) bv[bj][n] = *(const PG8_GAS f32x4*)(bp + bj * HALF + 4 * n);
        float rv[2][4]; rows_rinv(rv, ssq, u.pm * BM + wr * 64 + fr, fq);
        if (u.pn < 8) {
            const int col0 = u.pn * BM + wc * 32 + 8 * fq;
            const bool isv = u.pn >= 4;
#pragma unroll
            for (int ai = 0; ai < 2; ++ai)
#pragma unroll
                for (int m = 0; m < 4; ++m) {
                    const int row = u.pm * BM + ai * HALF + wr * 64 + m * 16 + fr;
                    const float rinv = rv[ai][m];
                    float s = 0.f, q = 0.f;
#pragma unroll
                    for (int bj = 0; bj < 2; ++bj) {
                        const f32x4 v0 = acc[ai][bj][m][0] * rinv + bv[bj][0], v1 = acc[ai][bj][m][1] * rinv + bv[bj][1];
                        const f32x2 a = gelu_pk((f32x2){v0[0], v0[1]}), b = gelu_pk((f32x2){v0[2], v0[3]}), c = gelu_pk((f32x2){v1[0], v1[1]}), d = gelu_pk((f32x2){v1[2], v1[3]});
                        s += (a.x + a.y) + (b.x + b.y) + (c.x + c.y) + (d.x + d.y);
                        q += (a.x * a.x + a.y * a.y) + (b.x * b.x + b.y * b.y) + (c.x * c.x + c.y * c.y) + (d.x * d.x + d.y * d.y);
                        u32x4 w; w.x = cvt_pk_bf16(a.x, a.y); w.y = cvt_pk_bf16(b.x, b.y); w.z = cvt_pk_bf16(c.x, c.y); w.w = cvt_pk_bf16(d.x, d.y);
                        *(PG8_GAS u32x4*)(UV + (size_t)row * 2048 + col0 + bj * HALF) = w;
                    }
                    if (isv) {
                        s += __shfl_xor(s, 16); s += __shfl_xor(s, 32); q += __shfl_xor(q, 16); q += __shfl_xor(q, 32);
                        if (fq == 0) { f32x2 o; o.x = s; o.y = q; *(PG8_GAS f32x2*)(vst + ((size_t)row * 16 + (u.pn - 4) * 4 + wc) * 2) = o; }
                    }
                }
        } else {
            const int hc0 = (u.pn - 8) * BM + wc * 32 + 8 * fq;
            const bool isctx = u.pm >= 128;
            const int b = isctx ? u.pm - 128 : (u.pm >> 3), t0 = isctx ? 0 : (u.pm & 7) * 256, nseq = isctx ? 256 : 2048;
            bf16_t* base = (isctx ? pt_ctx : pt_lat) + (size_t)b * 3072 * nseq;
#pragma unroll
            for (int ai = 0; ai < 2; ++ai)
#pragma unroll
                for (int m = 0; m < 4; ++m) {
                    const int t = t0 + ai * HALF + wr * 64 + m * 16 + fr;
                    const float rinv = rv[ai][m];
                    const bool odd = (fr & 1) != 0;
#pragma unroll
                    for (int bj = 0; bj < 2; ++bj)
#pragma unroll
                        for (int n = 0; n < 2; ++n) {
                            const f32x4 v = acc[ai][bj][m][n] * rinv + bv[bj][n];
#pragma unroll
                            for (int p = 0; p < 2; ++p) {
                                const float va = v[2 * p], vb = v[2 * p + 1];
                                const float send = odd ? va : vb, mine = odd ? vb : va;
                                const float recv = __builtin_bit_cast(float, __builtin_amdgcn_update_dpp(0, __builtin_bit_cast(int, send), 0xB1, 0xF, 0xF, true));
                                const unsigned w = odd ? cvt_pk_bf16(recv, mine) : cvt_pk_bf16(mine, recv);
                                const int col = hc0 + bj * HALF + 4 * n + 2 * p + (odd ? 1 : 0);
                                *(PG8_GAS unsigned*)(base + (size_t)col * nseq + (odd ? t - 1 : t)) = w;
                            }
                        }
                }
        }
    }
};

struct EpiRes {
    static constexpr bool PERM = false, AFTER_DRAIN = false;
    const float* src_lat; const float* src_ctx; float* dst_lat; float* dst_ctx; const float* gate;
    const float* ng; const float* nsc; bf16_t* xs; float* ssq;
    __device__ __forceinline__ void operator()(const f32x4 (&acc)[2][2][4][2], const Unit& u, int wr, int wc, int fr_, int fq) const {
        int fr = fr_; asm volatile("" : "+v"(fr));
        const bool isctx = u.pm >= 128;
        const int mr = isctx ? 16 : (u.pm >> 3);
        const size_t rb = (size_t)(isctx ? u.pm - 128 : u.pm) * BM * 1024;
        const float* src = (isctx ? src_ctx : src_lat) + rb; float* dst = (isctx ? dst_ctx : dst_lat) + rb;
        const int col0 = u.pn * BM + wc * 32 + 4 * fq;
        const bool nx = ng != nullptr;
        f32x4 gv[2][2], gs[2][2];
#pragma unroll
        for (int bj = 0; bj < 2; ++bj)
#pragma unroll
            for (int n = 0; n < 2; ++n) { gv[bj][n] = *(const PG8_GAS f32x4*)(gate + (size_t)mr * 6144 + col0 + bj * HALF + n * 16);
                gs[bj][n] = nx ? *(const PG8_GAS f32x4*)(ng + col0 + bj * HALF + n * 16) * (*(const PG8_GAS f32x4*)(nsc + (size_t)mr * 6144 + col0 + bj * HALF + n * 16) + 1.f) : (f32x4){0.f, 0.f, 0.f, 0.f}; }
#pragma unroll
        for (int ai = 0; ai < 2; ++ai)
#pragma unroll
          for (int mp = 0; mp < 2; ++mp) {
            f32x4 bs[2][2][2];
#pragma unroll
            for (int mm = 0; mm < 2; ++mm)
#pragma unroll
                for (int bj = 0; bj < 2; ++bj)
#pragma unroll
                    for (int n = 0; n < 2; ++n) bs[mm][bj][n] = *(const PG8_GAS f32x4*)(src + (size_t)(ai * HALF + wr * 64 + (2 * mp + mm) * 16 + fr) * 1024 + col0 + bj * HALF + n * 16);
#pragma unroll
            for (int mm = 0; mm < 2; ++mm) {
                const int m = 2 * mp + mm;
                const int r = ai * HALF + wr * 64 + m * 16 + fr;
                const size_t off = (size_t)r * 1024 + col0;
                const size_t grow = (size_t)u.pm * BM + r;
                float q = 0.f;
#pragma unroll
                for (int bj = 0; bj < 2; ++bj)
#pragma unroll
                    for (int n = 0; n < 2; ++n) { const f32x4 xn = bs[mm][bj][n] + gv[bj][n] * acc[ai][bj][m][n];
                        *(PG8_GAS f32x4*)(dst + off + bj * HALF + n * 16) = xn;
                        if (nx) { q += (xn[0] * xn[0] + xn[1] * xn[1]) + (xn[2] * xn[2] + xn[3] * xn[3]); const f32x4 y = xn * gs[bj][n];
                            typedef unsigned u32x2v __attribute__((ext_vector_type(2))); u32x2v w; w.x = cvt_pk_bf16(y[0], y[1]); w.y = cvt_pk_bf16(y[2], y[3]);
                            *(PG8_GAS u32x2v*)(xs + grow * 1024 + col0 + bj * HALF + n * 16) = w; } }
                if (nx) { q += __shfl_xor(q, 16); q += __shfl_xor(q, 32); if (fq == 0) ((PG8_GAS float*)ssq)[grow * 16 + u.pn * 4 + wc] = q; }
            }
            asm volatile("" ::: "memory");
          }
    }
};

struct EpiSwiGLU {
    static constexpr bool PERM = true, AFTER_DRAIN = false;
    bf16_t* act; const float* ssq; const float* bias;
    __device__ __forceinline__ void operator()(const f32x4 (&acc)[2][2][4][2], const Unit& u, int wr, int wc, int fr_, int fq) const {
        int fr = fr_; asm volatile("" : "+v"(fr));
        const int j0 = u.pn * 128 + wc * 16 + 4 * fq;
        const float* bp = bias + (size_t)(u.pm < 128 ? (u.pm >> 3) : 16) * 5632 + j0;
        f32x4 bg[2], bu[2];
#pragma unroll
        for (int bj = 0; bj < 2; ++bj) { bg[bj] = *(const PG8_GAS f32x4*)(bp + bj * 64); bu[bj] = *(const PG8_GAS f32x4*)(bp + 2816 + bj * 64); }
        float rv[2][4]; rows_rinv(rv, ssq, u.pm * BM + wr * 64 + fr, fq);
#pragma unroll
        for (int ai = 0; ai < 2; ++ai)
#pragma unroll
            for (int m = 0; m < 4; ++m) {
                const int row = u.pm * BM + ai * HALF + wr * 64 + m * 16 + fr;
                const float rinv = rv[ai][m];
#pragma unroll
                for (int bj = 0; bj < 2; ++bj) {
                    const f32x4 v0 = acc[ai][bj][m][0] * rinv + (f32x4){bg[bj][0], bu[bj][0], bg[bj][1], bu[bj][1]}, v1 = acc[ai][bj][m][1] * rinv + (f32x4){bg[bj][2], bu[bj][2], bg[bj][3], bu[bj][3]};
                    const float a0 = v0[0] * __builtin_amdgcn_rcpf(1.f + __expf(-v0[0])) * v0[1];
                    const float a1 = v0[2] * __builtin_amdgcn_rcpf(1.f + __expf(-v0[2])) * v0[3];
                    const float a2 = v1[0] * __builtin_amdgcn_rcpf(1.f + __expf(-v1[0])) * v1[1];
                    const float a3 = v1[2] * __builtin_amdgcn_rcpf(1.f + __expf(-v1[2])) * v1[3];
                    typedef unsigned u32x2v __attribute__((ext_vector_type(2)));
                    u32x2v w; w.x = cvt_pk_bf16(a0, a1); w.y = cvt_pk_bf16(a2, a3);
                    *(PG8_GAS u32x2v*)(act + (size_t)row * 2816 + j0 + bj * 64) = w;
                }
            }
    }
};

struct EpiQKV {
    static constexpr bool PERM = true, AFTER_DRAIN = false;
    bf16_t* Q; bf16_t* Kb; bf16_t* Vb; const float* ssq; const float* bias;
    __device__ __forceinline__ void operator()(const f32x4 (&acc)[2][2][4][2], const Unit& u, int wr, int wc, int fr_, int fq) const {
        int fr = fr_; asm volatile("" : "+v"(fr));
        bf16_t* base; int ld;
        if (u.pn < 4) { base = Q + (size_t)u.pm * BM * 1024 + u.pn * BM; ld = 1024; }
        else { const int kvrow = (u.pm < 128) ? (u.pm >> 3) * 2304 + 256 + (u.pm & 7) * 256 : (u.pm - 128) * 2304; base = (u.pn == 4 ? Kb : Vb) + (size_t)kvrow * 256; ld = 256; }
        const int col0 = wc * 32 + 8 * fq;
        const float* bp = bias + (size_t)(u.pm < 128 ? (u.pm >> 3) : 16) * 1536 + u.pn * BM + col0;
        f32x4 bv[2][2];
#pragma unroll
        for (int bj = 0; bj < 2; ++bj)
#pragma unroll
            for (int n = 0; n < 2; ++n) bv[bj][n] = *(const PG8_GAS f32x4*)(bp + bj * HALF + 4 * n);
        float rv[2][4]; rows_rinv(rv, ssq, u.pm * BM + wr * 64 + fr, fq);
#pragma unroll
        for (int ai = 0; ai < 2; ++ai)
#pragma unroll
            for (int m = 0; m < 4; ++m) {
                bf16_t* rowp = base + (size_t)(ai * HALF + wr * 64 + m * 16 + fr) * ld + col0;
                const float rinv = rv[ai][m];
#pragma unroll
                for (int bj = 0; bj < 2; ++bj) {
                    const f32x4 v0 = acc[ai][bj][m][0] * rinv + bv[bj][0], v1 = acc[ai][bj][m][1] * rinv + bv[bj][1];
                    u32x4 w; w.x = cvt_pk_bf16(v0[0], v0[1]); w.y = cvt_pk_bf16(v0[2], v0[3]); w.z = cvt_pk_bf16(v1[0], v1[1]); w.w = cvt_pk_bf16(v1[2], v1[3]);
                    *(PG8_GAS u32x4*)(rowp + bj * HALF) = w;
                }
            }
    }
};

template <class Epi, class Sched, bool ALIGN_EPI = false, bool SP2 = false>
__device__ __forceinline__ void gemm_phase(PG8_LAS unsigned char* lds, const Gemm g, const Sched& S, const Epi& E) {
    const int tid = OTID(), wid = __builtin_amdgcn_readfirstlane(tid >> 6), lane = tid & 63, wr = wid >> 2, wc = wid & 3, fr = lane & 15, fq = lane >> 4;
    const int K = g.K, nt = K / BK;
    unsigned voffA[2], voffB[2];
#pragma unroll
    for (int i = 0; i < 2; ++i) { int R, C; stage_rc(tid * 16 + i * 8192, R, C); const int Rb = Epi::PERM ? ((R & ~31) + perm32(R & 31)) : R;
        voffA[i] = (unsigned)(R * K + C) * 2u; voffB[i] = (unsigned)(Rb * K + C) * 2u; }
    const size_t kstep = (size_t)(BK * 2);
    const size_t hstep = (size_t)HALF * K * 2;
    const size_t tstep = 2 * hstep;
    const unsigned ldsw = (unsigned)wid * 1024u;
    const int aoff = lds_byte(wr * 64 + fr, fq * 8), boff = lds_byte(wc * 32 + fr, fq * 8);
#define PG8_SA(b, h) (((b) * 2 + (h)) * HTB)
#define PG8_SB(b, h) ((4 + (b) * 2 + (h)) * HTB)
#define PG8_STAGE(bufoff, gbase, voff) do { _Pragma("unroll") for (int _i = 0; _i < 2; ++_i) \
        __builtin_amdgcn_global_load_lds((const unsigned*)((const char*)(gbase) + (voff)[_i]), (PG8_LAS unsigned*)(lds + (bufoff) + ldsw + _i * 8192), 16, 0, 0); } while (0)
#define PG8_LDA(dst, b, h) do { _Pragma("unroll") for (int m = 0; m < 4; ++m) _Pragma("unroll") for (int k = 0; k < 2; ++k) dst[m][k] = *(const PG8_LAS bf16x8*)(lds + PG8_SA(b, h) + aoff + m * 2048 + k * 1024); } while (0)
#define PG8_LDB(dst, b, h) do { _Pragma("unroll") for (int n = 0; n < 2; ++n) _Pragma("unroll") for (int k = 0; k < 2; ++k) dst[n][k] = *(const PG8_LAS bf16x8*)(lds + PG8_SB(b, h) + boff + n * 2048 + k * 1024); } while (0)
#define PG8_MMA(ai, bj, At, Bt) do { __builtin_amdgcn_s_setprio(1); _Pragma("unroll") for (int m = 0; m < 4; ++m) _Pragma("unroll") for (int n = 0; n < 2; ++n) _Pragma("unroll") for (int k = 0; k < 2; ++k) \
        acc[ai][bj][m][n] = __builtin_amdgcn_mfma_f32_16x16x32_bf16(Bt[n][k], At[m][k], acc[ai][bj][m][n], 0, 0, 0); __builtin_amdgcn_s_setprio(0); } while (0)
#define PG8_WAIT_V(n) asm volatile("s_waitcnt vmcnt(" #n ")" ::: "memory")
#define PG8_WAIT_L(n) asm volatile("s_waitcnt lgkmcnt(" #n ")" ::: "memory")
#define PG8_BAR __builtin_amdgcn_s_barrier()
#define PG8_SCHED __builtin_amdgcn_sched_barrier(0)
    Unit cur, nxt; int ui = 0;
    if (!S.next(0, cur)) return;
    f32x4 acc[2][2][4][2];
#pragma unroll
    for (int a = 0; a < 2; ++a)
#pragma unroll
        for (int b = 0; b < 2; ++b)
#pragma unroll
            for (int m = 0; m < 4; ++m)
#pragma unroll
                for (int n = 0; n < 2; ++n) acc[a][b][m][n] = (f32x4){0.f, 0.f, 0.f, 0.f};
    bf16x8 At[4][2], B0[2][2], B1[2][2];
    const char* cA = (const char*)g.A + (size_t)cur.pm * tstep; const char* cB = (const char*)g.Bt + (size_t)cur.pn * tstep;
    S.a_ready(cur);
    if constexpr (SP2) {
        PG8_STAGE(PG8_SB(0, 0), cB, voffB); PG8_STAGE(PG8_SB(0, 1), cB + hstep, voffB); PG8_STAGE(PG8_SA(0, 0), cA, voffA); PG8_STAGE(PG8_SA(0, 1), cA + hstep, voffA);
        if (wr == 1) PG8_BAR;
        PG8_WAIT_V(2); PG8_BAR;
        PG8_STAGE(PG8_SB(1, 0), cB + kstep, voffB); PG8_STAGE(PG8_SA(1, 0), cA + kstep, voffA); PG8_STAGE(PG8_SB(1, 1), cB + hstep + kstep, voffB);
        PG8_WAIT_V(6); PG8_BAR;
    } else {
        PG8_STAGE(PG8_SB(0, 0), cB, voffB); PG8_STAGE(PG8_SA(0, 0), cA, voffA); PG8_STAGE(PG8_SB(0, 1), cB + hstep, voffB); PG8_STAGE(PG8_SA(0, 1), cA + hstep, voffA);
        if (wr == 1) PG8_BAR;
        PG8_WAIT_V(4); PG8_BAR;
        PG8_STAGE(PG8_SB(1, 0), cB + kstep, voffB); PG8_STAGE(PG8_SA(1, 0), cA + kstep, voffA); PG8_STAGE(PG8_SB(1, 1), cB + hstep + kstep, voffB);
        PG8_WAIT_V(6); PG8_BAR;
    }
    for (;;) {
        const bool has_next = S.next(ui + 1, nxt);
        const char* nA = has_next ? (const char*)g.A + (size_t)nxt.pm * tstep : cA; const char* nB = has_next ? (const char*)g.Bt + (size_t)nxt.pn * tstep : cB;
        for (int t = 0; t < nt; t += 2) {
            const bool last = (t == nt - 2);
            const char* a1 = cA + (size_t)(t + 1) * kstep;
            const char* a2 = last ? nA : cA + (size_t)(t + 2) * kstep; const char* b2 = last ? nB : cB + (size_t)(t + 2) * kstep;
            const char* a3 = a2 + kstep; const char* b3 = b2 + kstep;
            if (last && has_next) S.a_ready(nxt);
            if constexpr (SP2) {
            PG8_LDB(B0, 0, 0); PG8_LDB(B1, 0, 1); PG8_SCHED; PG8_LDA(At, 0, 0); PG8_STAGE(PG8_SA(1, 1), a1 + hstep, voffA);
            PG8_WAIT_V(8); PG8_WAIT_L(0); PG8_BAR; PG8_MMA(0, 0, At, B0); PG8_MMA(0, 1, At, B1); PG8_BAR; PG8_SCHED;
            PG8_LDA(At, 0, 1); PG8_STAGE(PG8_SB(0, 0), b2, voffB); PG8_STAGE(PG8_SB(0, 1), b2 + hstep, voffB); PG8_STAGE(PG8_SA(0, 0), a2, voffA);
            PG8_WAIT_V(8); PG8_WAIT_L(0); PG8_BAR; PG8_MMA(1, 0, At, B0); PG8_MMA(1, 1, At, B1); PG8_BAR; PG8_SCHED;
            PG8_LDB(B0, 1, 0); PG8_LDB(B1, 1, 1); PG8_SCHED; PG8_LDA(At, 1, 0); PG8_STAGE(PG8_SA(0, 1), a2 + hstep, voffA);
            PG8_WAIT_V(8); PG8_WAIT_L(0); PG8_BAR; PG8_MMA(0, 0, At, B0); PG8_MMA(0, 1, At, B1); PG8_BAR; PG8_SCHED;
            PG8_LDA(At, 1, 1); PG8_STAGE(PG8_SB(1, 0), b3, voffB); PG8_STAGE(PG8_SB(1, 1), b3 + hstep, voffB); PG8_STAGE(PG8_SA(1, 0), a3, voffA);
            PG8_WAIT_V(8); PG8_WAIT_L(0); PG8_BAR; PG8_MMA(1, 0, At, B0); PG8_MMA(1, 1, At, B1); PG8_BAR; PG8_SCHED;
            } else {
            PG8_LDB(B0, 0, 0); PG8_SCHED; PG8_LDA(At, 0, 0); PG8_STAGE(PG8_SA(1, 1), a1 + hstep, voffA);
            PG8_WAIT_L(8); PG8_BAR; PG8_WAIT_L(0); PG8_MMA(0, 0, At, B0); PG8_BAR; PG8_SCHED;
            PG8_LDB(B1, 0, 1); PG8_STAGE(PG8_SB(0, 0), b2, voffB);
            PG8_BAR; PG8_WAIT_L(0); PG8_MMA(0, 1, At, B1); PG8_BAR;
            PG8_LDA(At, 0, 1); PG8_STAGE(PG8_SA(0, 0), a2, voffA);
            PG8_BAR; PG8_WAIT_L(0); PG8_MMA(1, 0, At, B0); PG8_BAR; PG8_SCHED;
            PG8_STAGE(PG8_SB(0, 1), b2 + hstep, voffB);
            PG8_WAIT_V(6); PG8_BAR; PG8_MMA(1, 1, At, B1); PG8_BAR;
            PG8_LDB(B0, 1, 0); PG8_SCHED; PG8_LDA(At, 1, 0); PG8_STAGE(PG8_SA(0, 1), a2 + hstep, voffA);
            PG8_WAIT_L(8); PG8_BAR; PG8_WAIT_L(0); PG8_MMA(0, 0, At, B0); PG8_BAR; PG8_SCHED;
            PG8_LDB(B1, 1, 1); PG8_STAGE(PG8_SB(1, 0), b3, voffB);
            PG8_BAR; PG8_WAIT_L(0); PG8_MMA(0, 1, At, B1); PG8_BAR;
            PG8_LDA(At, 1, 1); PG8_STAGE(PG8_SA(1, 0), a3, voffA);
            PG8_BAR; PG8_WAIT_L(0); PG8_MMA(1, 0, At, B0); PG8_BAR; PG8_SCHED;
            PG8_STAGE(PG8_SB(1, 1), b3 + hstep, voffB);
            PG8_WAIT_V(6); PG8_BAR; PG8_MMA(1, 1, At, B1); PG8_BAR;
            }
        }
        if constexpr (ALIGN_EPI) { if (wr == 0) PG8_BAR; }
        if constexpr (!Epi::AFTER_DRAIN) { E(acc, cur, wr, wc, fr, fq); S.done(cur); }
        if (!has_next) break;
#pragma unroll
        for (int a = 0; a < 2; ++a)
#pragma unroll
            for (int b = 0; b < 2; ++b)
#pragma unroll
                for (int m = 0; m < 4; ++m)
#pragma unroll
                    for (int n = 0; n < 2; ++n) acc[a][b][m][n] = (f32x4){0.f, 0.f, 0.f, 0.f};
        cur = nxt; cA = nA; cB = nB; ++ui;
        if constexpr (ALIGN_EPI) { if (wr == 1) PG8_BAR; }
    }
    PG8_WAIT_V(0);
    if constexpr (!ALIGN_EPI) { if (wr == 0) PG8_BAR; }
    PG8_BAR;
    if constexpr (Epi::AFTER_DRAIN) { E.fused(acc, cur, wr, wc, fr, fq, lds, wid, lane); S.done(cur); }
#undef PG8_SA
#undef PG8_SB
#undef PG8_STAGE
#undef PG8_LDA
#undef PG8_LDB
#undef PG8_MMA
#undef PG8_WAIT_V
#undef PG8_WAIT_L
#undef PG8_BAR
#undef PG8_SCHED
}
}
namespace att {
using bf16 = __hip_bfloat16;
constexpr int   D = 128, NW = 8, QBLK = 32, KVBLK = 64;
constexpr float SCALE = 0.088388347648318440f;
constexpr float THR = 8.f;
constexpr int SDEPTH = 2;
constexpr int LDQ = 1024, LDK = 256, LDO = 1024;
constexpr size_t SHM_V = KVBLK * D * 2, SHM_K = KVBLK * D * 2, SHM_ATTN = 2 * SHM_V + 2 * SHM_K + NW * 64 * 4;
using bf16x8 = __attribute__((ext_vector_type(8))) short;
using s16x4  = __attribute__((ext_vector_type(4))) short;
using f32x16 = __attribute__((ext_vector_type(16))) float;
using f32x8  = __attribute__((ext_vector_type(8))) float;
using u32x4  = __attribute__((ext_vector_type(4))) unsigned;
#define KSWZ(row, colB) ((row) * 256 + ((colB) ^ (((row) & 7) << 4)))
#define SBAR() __builtin_amdgcn_sched_barrier(0)
__device__ __forceinline__ int crow(int r, int hi) { return (r & 3) + 8 * (r >> 2) + 4 * hi; }
__device__ __forceinline__ unsigned cvtpk(float lo, float hi) {
  unsigned r; asm volatile("v_cvt_pk_bf16_f32 %0, %1, %2" : "=v"(r) : "v"(lo), "v"(hi)); return r;
}
template <typename TIn> struct Stage;
template <> struct Stage<bf16>  { using T = bf16x8;
  __device__ static __forceinline__ T ld8(const bf16* p) { return *(const __attribute__((address_space(1))) bf16x8*)(p); }
  __device__ static __forceinline__ bf16x8 tobf(T x) { return x; } };
template <> struct Stage<float> { using T = f32x8;
  __device__ static __forceinline__ T ld8(const float* p) { return *reinterpret_cast<const f32x8*>(p); }
  __device__ static __forceinline__ bf16x8 tobf(T x) {
    u32x4 w = {cvtpk(x[0], x[1]), cvtpk(x[2], x[3]), cvtpk(x[4], x[5]), cvtpk(x[6], x[7])}; return *reinterpret_cast<bf16x8*>(&w); } };

__device__ __forceinline__ void partialSM(f32x16& p0, f32x16& p1, float& m_reg, float& mn, float& alpha) {
  constexpr float C = SCALE * 1.4426950408889634f;
  float pmax = p0[0]; for (int r = 1; r < 16; ++r) pmax = fmaxf(pmax, p0[r]); for (int r = 0; r < 16; ++r) pmax = fmaxf(pmax, p1[r]);
  { auto rr = __builtin_amdgcn_permlane32_swap(__float_as_uint(pmax), __float_as_uint(pmax), false, false);
    pmax = fmaxf(__uint_as_float(rr[0]), __uint_as_float(rr[1])); }
  if (__builtin_expect(__all(pmax - m_reg <= THR / SCALE), 1)) { mn = m_reg; alpha = 1.f; }
  else { mn = fmaxf(m_reg, pmax); alpha = __builtin_amdgcn_exp2f((m_reg - mn) * C); m_reg = mn; }
  float mnC = -mn * C;
  for (int r = 0; r < 16; ++r) p0[r] = fmaf(p0[r], C, mnC); for (int r = 0; r < 16; ++r) p1[r] = fmaf(p1[r], C, mnC);
  for (int r = 0; r < 16; ++r) p0[r] = __builtin_amdgcn_exp2f(p0[r]);
}
__device__ __forceinline__ void finishSM(f32x16& p0, f32x16& p1, float alpha, float& l_reg, bf16x8& pa0, bf16x8& pa1, bf16x8& pa2, bf16x8& pa3) {
  for (int r = 0; r < 16; ++r) p1[r] = __builtin_amdgcn_exp2f(p1[r]);
  float ps = 0; for (int r = 0; r < 16; ++r) ps += p0[r]; for (int r = 0; r < 16; ++r) ps += p1[r];
  { auto rr = __builtin_amdgcn_permlane32_swap(__float_as_uint(ps), __float_as_uint(ps), false, false);
    ps = __uint_as_float(rr[0]) + __uint_as_float(rr[1]); }
  l_reg = l_reg * alpha + ps;
#define PK4(P, BASE, OUT) do { unsigned a0 = cvtpk(P[BASE + 0], P[BASE + 1]), a1 = cvtpk(P[BASE + 2], P[BASE + 3]);   \
    unsigned b0 = cvtpk(P[BASE + 4], P[BASE + 5]), b1 = cvtpk(P[BASE + 6], P[BASE + 7]);                              \
    auto r0 = __builtin_amdgcn_permlane32_swap(a0, b0, false, false); auto r1 = __builtin_amdgcn_permlane32_swap(a1, b1, false, false); \
    u32x4 w = {r0[0], r1[0], r0[1], r1[1]}; OUT = *reinterpret_cast<bf16x8*>(&w); } while (0)
  PK4(p0, 0, pa0); PK4(p0, 8, pa1); PK4(p1, 0, pa2); PK4(p1, 8, pa3);
#undef PK4
}
__device__ __forceinline__ void qkt(f32x16& p0, f32x16& p1, const bf16* Ks, const bf16x8* qr, int r32, int hi) {
  p0 = f32x16{}; p1 = f32x16{};
  for (int d0 = 0; d0 < 8; ++d0) { int cb = (d0 * 16 + hi * 8) * 2;
    bf16x8 b0 = *reinterpret_cast<const bf16x8*>((const char*)Ks + KSWZ(r32, cb));
    bf16x8 b1 = *reinterpret_cast<const bf16x8*>((const char*)Ks + KSWZ(32 + r32, cb));
    p0 = __builtin_amdgcn_mfma_f32_32x32x16_bf16(b0, qr[d0], p0, 0, 0, 0);
    p1 = __builtin_amdgcn_mfma_f32_32x32x16_bf16(b1, qr[d0], p1, 0, 0, 0); }
}
__device__ __forceinline__ int v_st(int k, int c) { const int kk = (k & ~0xC) | ((k & 4) << 1) | ((k & 8) >> 1); return ((kk >> 3) * 4 + (c >> 5)) * 512 + ((kk & 7) * 32 + (c & 31)) * 2; }
__device__ __forceinline__ int v_rd_base(int lane) { return ((lane & 3) << 3) | (((lane >> 2) & 3) << 6) | (((lane >> 4) & 1) << 5) | (((lane >> 5) & 1) << 8); }
constexpr int v_rd_off(int d0, int ks, int half) { return d0 * 512 + ks * 4096 + half * 2048; }
template <int OFF> __device__ __forceinline__ s16x4 tr_read(int vb) {
  s16x4 r; asm volatile("ds_read_b64_tr_b16 %0, %1 offset:%2" : "=&v"(r) : "v"(vb), "i"(OFF) : "memory"); return r;
}
template <int D0> __device__ __forceinline__ void pv_one(f32x16& od, int vb, bf16x8 pa0, bf16x8 pa1, bf16x8 pa2, bf16x8 pa3) {
  const s16x4 l0 = tr_read<v_rd_off(D0, 0, 0)>(vb), h0 = tr_read<v_rd_off(D0, 0, 1)>(vb), l1 = tr_read<v_rd_off(D0, 1, 0)>(vb), h1 = tr_read<v_rd_off(D0, 1, 1)>(vb);
  const s16x4 l2 = tr_read<v_rd_off(D0, 2, 0)>(vb), h2 = tr_read<v_rd_off(D0, 2, 1)>(vb), l3 = tr_read<v_rd_off(D0, 3, 0)>(vb), h3 = tr_read<v_rd_off(D0, 3, 1)>(vb);
  asm volatile("s_waitcnt lgkmcnt(0)" ::: "memory"); SBAR();
#define PK(L, H) (bf16x8){L[0], L[1], L[2], L[3], H[0], H[1], H[2], H[3]}
  od = __builtin_amdgcn_mfma_f32_32x32x16_bf16(pa0, PK(l0, h0), od, 0, 0, 0);
  od = __builtin_amdgcn_mfma_f32_32x32x16_bf16(pa1, PK(l1, h1), od, 0, 0, 0);
  od = __builtin_amdgcn_mfma_f32_32x32x16_bf16(pa2, PK(l2, h2), od, 0, 0, 0);
  od = __builtin_amdgcn_mfma_f32_32x32x16_bf16(pa3, PK(l3, h3), od, 0, 0, 0);
#undef PK
}
__device__ __forceinline__ void pv_d0(f32x16* o, int vb, bf16x8 pa0, bf16x8 pa1, bf16x8 pa2, bf16x8 pa3) {
  pv_one<0>(o[0], vb, pa0, pa1, pa2, pa3); pv_one<1>(o[1], vb, pa0, pa1, pa2, pa3); pv_one<2>(o[2], vb, pa0, pa1, pa2, pa3); pv_one<3>(o[3], vb, pa0, pa1, pa2, pa3);
}

template <typename TQ>
__device__ __forceinline__ void attn_dense_body(const TQ* __restrict__ Qb, const bf16* __restrict__ Kh, const bf16* __restrict__ Vh,
                                                bf16* __restrict__ Ob, int seq, char* lds, const float* __restrict__ qg, int pos0) {
  using St = Stage<bf16>; using SQ = Stage<TQ>;
  const int tid = OTID(), wid = tid >> 6, lane = tid & 63, r32 = lane & 31, hi = lane >> 5;
  bf16* V_lds = (bf16*)lds; bf16* K_lds = (bf16*)(lds + 2 * SHM_V);
  float* ws = (float*)(lds + 2 * SHM_V + 2 * SHM_K) + wid * 64; float* li_l = ws; float* al_l = ws + 32;
  float m_reg = -1e30f, l_reg = 0; f32x16 o[4] = {}; bf16x8 qr[8];
  const TQ* Qw = Qb + (long)(wid * QBLK + r32) * LDQ + hi * 8;
#pragma unroll
  for (int d0 = 0; d0 < 8; ++d0) qr[d0] = SQ::tobf(SQ::ld8(Qw + d0 * 16));
  {
    float qf[8][8]; float ss = 0.f;
#pragma unroll
    for (int d0 = 0; d0 < 8; ++d0)
#pragma unroll
      for (int e = 0; e < 8; ++e) { const float v = __builtin_bit_cast(float, (unsigned)(unsigned short)qr[d0][e] << 16); qf[d0][e] = v; ss += v * v; }
    { auto rr = __builtin_amdgcn_permlane32_swap(__float_as_uint(ss), __float_as_uint(ss), false, false); ss = __uint_as_float(rr[0]) + __uint_as_float(rr[1]); }
    const float rinv = rsqrtf(ss * (1.f / 128.f) + 1e-6f);
#pragma unroll
    for (int d0 = 0; d0 < 8; ++d0) {
      const float4 g0 = *reinterpret_cast<const float4*>(qg + d0 * 16 + hi * 8), g1 = *reinterpret_cast<const float4*>(qg + d0 * 16 + hi * 8 + 4);
      qf[d0][0] *= rinv * g0.x; qf[d0][1] *= rinv * g0.y; qf[d0][2] *= rinv * g0.z; qf[d0][3] *= rinv * g0.w;
      qf[d0][4] *= rinv * g1.x; qf[d0][5] *= rinv * g1.y; qf[d0][6] *= rinv * g1.z; qf[d0][7] *= rinv * g1.w;
    }
    if (pos0 >= 0) {
      const int t = pos0 + wid * QBLK + r32; const float prow = (float)(t >> 6), pcol = (float)(t & 63);
#pragma unroll
      for (int d0 = 0; d0 < 4; ++d0)
#pragma unroll
        for (int e = 0; e < 8; ++e) {
          const int i = d0 * 16 + hi * 8 + e;
          const float inv = exp2f(-(float)(i & 31) * (13.287712379549449f / 32.f));
          const float ang = (d0 < 2 ? prow : pcol) * inv; const float cs = __cosf(ang), sn = __sinf(ang);
          const float x1 = qf[d0][e], x2 = qf[d0 + 4][e];
          qf[d0][e] = x1 * cs - x2 * sn; qf[d0 + 4][e] = x2 * cs + x1 * sn;
        }
    }
#pragma unroll
    for (int d0 = 0; d0 < 8; ++d0) { u32x4 w = {cvtpk(qf[d0][0], qf[d0][1]), cvtpk(qf[d0][2], qf[d0][3]), cvtpk(qf[d0][4], qf[d0][5]), cvtpk(qf[d0][6], qf[d0][7])}; qr[d0] = *reinterpret_cast<bf16x8*>(&w); }
  }
  const int sr = tid >> 4, sc = (tid & 15) * 8, vst0 = v_st(sr, sc), vst1 = v_st(32 + sr, sc);
  const int vb0 = (int)(uintptr_t)V_lds + v_rd_base(lane);
  struct { typename St::T vs0, vs1, ks0, ks1; } sr_[SDEPTH];
#define SLOAD(i, k0) do { sr_[i].vs0 = St::ld8(&Vh[(long)((k0) + sr) * LDK + sc]); sr_[i].vs1 = St::ld8(&Vh[(long)((k0) + 32 + sr) * LDK + sc]); \
    sr_[i].ks0 = St::ld8(&Kh[(long)((k0) + sr) * LDK + sc]); sr_[i].ks1 = St::ld8(&Kh[(long)((k0) + 32 + sr) * LDK + sc]); } while (0)
#define SWRITE(b, i) do { *(bf16x8*)((char*)V_lds + (b) * SHM_V + vst0) = St::tobf(sr_[i].vs0);          \
    *(bf16x8*)((char*)V_lds + (b) * SHM_V + vst1) = St::tobf(sr_[i].vs1); int kc = sc * 2;               \
    *(bf16x8*)((char*)K_lds + (b) * SHM_K + KSWZ(sr, kc)) = St::tobf(sr_[i].ks0);                       \
    *(bf16x8*)((char*)K_lds + (b) * SHM_K + KSWZ(32 + sr, kc)) = St::tobf(sr_[i].ks1); } while (0)
#define SWAIT() do { if constexpr (SDEPTH == 2) asm volatile("s_waitcnt vmcnt(4)" ::: "memory"); else asm volatile("s_waitcnt vmcnt(0)" ::: "memory"); } while (0)
#define RESC(a) do { if (__any((a) < 1.f)) { if (hi == 0) al_l[r32] = (a); asm volatile("s_waitcnt lgkmcnt(0)" ::: "memory"); \
    for (int d = 0; d < 4; ++d) for (int r = 0; r < 16; ++r) o[d][r] *= al_l[crow(r, hi)]; } } while (0)
  f32x16 pA0, pA1, pB0, pB1; float mnA, mnB, alA, alB; bf16x8 pa0, pa1, pa2, pa3; const int NT = seq / KVBLK;
  constexpr int SE = 0, SO = SDEPTH - 1;
  SLOAD(SE, 0); asm volatile("s_waitcnt vmcnt(0)" ::: "memory"); SWRITE(0, SE); __syncthreads();
  qkt(pA0, pA1, K_lds, qr, r32, hi); partialSM(pA0, pA1, m_reg, mnA, alA);
  SLOAD(SO, KVBLK); if constexpr (SDEPTH == 2) { if (2 < NT) SLOAD(SE, 2 * KVBLK); }
  SWAIT(); SWRITE(1, SO); __syncthreads();
  for (int j = 1; j + 1 < NT; j += 2) {
    SBAR(); qkt(pB0, pB1, (bf16*)((char*)K_lds + SHM_K), qr, r32, hi);
    finishSM(pA0, pA1, alA, l_reg, pa0, pa1, pa2, pa3); SBAR();
    SLOAD(SO, (j + SDEPTH) * KVBLK); SBAR();
    pv_d0(o, vb0, pa0, pa1, pa2, pa3); partialSM(pB0, pB1, m_reg, mnB, alB);
    __syncthreads(); SWAIT(); SWRITE(0, SE);
    RESC(alB); __syncthreads();
    SBAR(); qkt(pA0, pA1, K_lds, qr, r32, hi);
    finishSM(pB0, pB1, alB, l_reg, pa0, pa1, pa2, pa3); SBAR();
    if (SDEPTH == 1 || j + 3 < NT) SLOAD(SE, (j + 1 + SDEPTH) * KVBLK); SBAR();
    pv_d0(o, vb0 + (int)SHM_V, pa0, pa1, pa2, pa3); partialSM(pA0, pA1, m_reg, mnA, alA);
    __syncthreads(); SWAIT(); SWRITE(1, SO);
    RESC(alA); __syncthreads();
  }
  SBAR(); qkt(pB0, pB1, (bf16*)((char*)K_lds + SHM_K), qr, r32, hi);
  finishSM(pA0, pA1, alA, l_reg, pa0, pa1, pa2, pa3); SBAR();
  pv_d0(o, vb0, pa0, pa1, pa2, pa3); partialSM(pB0, pB1, m_reg, mnB, alB);
  __syncthreads(); RESC(alB);
  finishSM(pB0, pB1, alB, l_reg, pa0, pa1, pa2, pa3); SBAR();
  pv_d0(o, vb0 + (int)SHM_V, pa0, pa1, pa2, pa3);
  if (hi == 0) li_l[r32] = l_reg; asm volatile("s_waitcnt lgkmcnt(0)" ::: "memory");
  float rli[16];
#pragma unroll
  for (int r = 0; r < 16; ++r) rli[r] = __builtin_amdgcn_rcpf(li_l[crow(r, hi)]);
  bf16* Ow = Ob + (long)(wid * QBLK) * LDO;
#pragma unroll
  for (int r = 0; r < 16; ++r) { int orow = crow(r, hi);
    for (int d0 = 0; d0 < 4; ++d0) ((__attribute__((address_space(1))) unsigned short*)Ow)[(long)orow * LDO + d0 * 32 + r32] = pg8::f2bf_rne(o[d0][r] * rli[r]); }
#undef SLOAD
#undef SWRITE
#undef SWAIT
#undef RESC
}
}

constexpr size_t MiB = 1u << 20;
constexpr size_t WS_MODS = 0;
constexpr size_t WS_VST  = 2 * MiB;
constexpr size_t WS_WMIX = 8 * MiB;
constexpr size_t WS_WMIX2 = 18 * MiB;
constexpr size_t WS_WGU  = 22 * MiB;
constexpr size_t WS_WDN  = 33 * MiB;
constexpr size_t WS_XCTX = 40 * MiB;
constexpr size_t WS_HMOD = 56 * MiB;
constexpr size_t WS_Z2T_CTX = WS_HMOD + 64 * MiB;
constexpr size_t WS_BIG  = 128 * MiB;
constexpr size_t WS_Q = WS_BIG, WS_K = WS_BIG + 72 * MiB, WS_V = WS_K + 18 * MiB, WS_O = WS_V + 18 * MiB;
constexpr size_t WS_PT_LAT = 272 * MiB;
constexpr size_t WS_PT_CTX = 464 * MiB;
constexpr size_t WS_EF_LAT = 488 * MiB;
constexpr size_t WS_EF_CTX = 504 * MiB;
constexpr size_t WS_SP_LAT = 506 * MiB;
constexpr size_t WS_SP_CTX = WS_SP_LAT + 65536;
constexpr size_t WS_SSQ = 507 * MiB;
constexpr size_t WS_BIAS = 509 * MiB + 512 * 1024;
constexpr size_t WS_END = 512 * MiB;
constexpr int LDS_BYTES = 155648;

#define LAS __attribute__((address_space(3)))
typedef unsigned short bf16_t;
typedef unsigned u32x4 __attribute__((ext_vector_type(4)));
typedef unsigned u32x2 __attribute__((ext_vector_type(2)));
typedef float f32x4 __attribute__((ext_vector_type(4)));
typedef float f32x2 __attribute__((ext_vector_type(2)));
typedef short bf16x8 __attribute__((ext_vector_type(8)));

__device__ __forceinline__ float bf2f(unsigned short h) { return __builtin_bit_cast(float, (unsigned)h << 16); }
__device__ __forceinline__ float bflo(unsigned w) { return __builtin_bit_cast(float, w << 16); }
__device__ __forceinline__ float bfhi(unsigned w) { return __builtin_bit_cast(float, w & 0xffff0000u); }
__device__ __forceinline__ unsigned pk2(float lo, float hi) { return pg8::cvt_pk_bf16(lo, hi); }
__device__ __forceinline__ float wave_sum(float v) {
#pragma unroll
    for (int o = 1; o < 64; o <<= 1) v += __shfl_xor(v, o);
    return v;
}

struct Args { const float* in[30]; float* out; unsigned char* ws; int ph_lo, ph_hi; };
typedef const __attribute__((address_space(4))) Args* ArgsP;
#define GAS __attribute__((address_space(1)))
__device__ __forceinline__ unsigned char* WSP(ArgsP a) { unsigned char* w = a->ws; asm volatile("" : "+s"(w)); return (unsigned char*)(GAS unsigned char*)w; }
#define AIN(i) ((const float*)(const GAS float*)(a->in[i]))
#define AOUT ((float*)(GAS float*)(a->out))
enum { I_X = 0, I_C, I_CTX, I_CCTX, I_MODW, I_MODB, I_N1G, I_N2G, I_WGU, I_WDN, I_WIN, I_LNG, I_LNB, I_WS, I_BS, I_CW, I_CB,
       I_FW1, I_FB1, I_FW2, I_FB2, I_FW3, I_FFREQ, I_SKIP, I_WOUT, I_WQKV, I_QG, I_KG, I_WO, I_FG };

__device__ __forceinline__ void gemv17_slice(f32x4 (&acc)[17], const float* W, size_t ldw, const float* cs, int kbeg) {
    const int kend = kbeg + 128;
    f32x4 r0[4], r1[4], r2[4], r3[4];
#define G17_LD(R, K0) { _Pragma("unroll") for (int i_ = 0; i_ < 4; ++i_) { const int kk_ = (K0) + i_ < kend ? (K0) + i_ : kend - 1; R[i_] = *(const f32x4*)(W + (size_t)kk_ * ldw); } }
#define G17_FMA(R, K0) { _Pragma("unroll") for (int rr_ = 0; rr_ < 17; ++rr_) { const f32x4 c4 = *(const f32x4*)(cs + rr_ * 1024 + (K0)); acc[rr_] += R[0] * c4.x + R[1] * c4.y + R[2] * c4.z + R[3] * c4.w; \
        if (rr_ % 4 == 3) __builtin_amdgcn_sched_barrier(0); } __builtin_amdgcn_sched_barrier(0); }
    G17_LD(r0, kbeg) G17_LD(r1, kbeg + 4) G17_LD(r2, kbeg + 8) G17_LD(r3, kbeg + 12)
    __builtin_amdgcn_sched_barrier(0);
#pragma unroll 1
    for (int k = kbeg; k < kend; k += 16) {
        G17_FMA(r0, k)      G17_LD(r0, k + 16) __builtin_amdgcn_sched_barrier(0);
        G17_FMA(r1, k + 4)  G17_LD(r1, k + 20) __builtin_amdgcn_sched_barrier(0);
        G17_FMA(r2, k + 8)  G17_LD(r2, k + 24) __builtin_amdgcn_sched_barrier(0);
        G17_FMA(r3, k + 12) G17_LD(r3, k + 28) __builtin_amdgcn_sched_barrier(0);
    }
#undef G17_LD
#undef G17_FMA
}

__device__ __forceinline__ void phase_mods(ArgsP a, unsigned char* lds) {
    const int tid = OTID(), lane = tid & 63, wave = tid >> 6;
    float* cs = (float*)lds;
    float* mods = (float*)(WSP(a) + WS_MODS);
    for (int unit = OBID(); unit < 96; unit += gridDim.x) {
#pragma unroll 1
        for (int h2 = 0; h2 < 2; ++h2) { float tv[17];
#pragma unroll
            for (int q = 0; q < 17; ++q) { const int i = tid + 512 * (17 * h2 + q), r = i >> 10, k = i & 1023; tv[q] = r < 16 ? ((const GAS float*)AIN(I_C))[r * 1024 + k] : ((const GAS float*)AIN(I_CCTX))[k]; }
#pragma unroll
            for (int q = 0; q < 17; ++q) cs[tid + 512 * (17 * h2 + q)] = tv[q] / (1.f + __expf(-tv[q])); }
        __syncthreads();
        const int l = unit / 24, n0 = (unit % 24) * 256;
        const float* W = AIN(I_MODW) + (size_t)l * 1024 * MODW + n0 + 4 * lane;
        f32x4 acc[17];
#pragma unroll
        for (int r = 0; r < 17; ++r) acc[r] = (f32x4){0.f, 0.f, 0.f, 0.f};
        gemv17_slice(acc, W, MODW, cs, wave * 128);
        __syncthreads();
#pragma unroll
        for (int r = 0; r < 17; ++r) *(f32x4*)(cs + ((wave * 17 + r) * 256 + 4 * lane)) = acc[r];
        __syncthreads();
        for (int i = tid; i < 17 * 256; i += 512) {
            const int r = i >> 8, cc = i & 255; float sacc = AIN(I_MODB)[l * MODW + n0 + cc];
#pragma unroll
            for (int w = 0; w < 8; ++w) sacc += cs[(w * 17 + r) * 256 + cc];
            mods[((size_t)l * 17 + r) * MODW + n0 + cc] = sacc;
        }
        __syncthreads();
    }
}

template <int MODE>
__device__ __forceinline__ void transpose_item(const float* W, int K, int N, bf16_t* WT, float* scr, int item, int lane) {
    const int nblk = N / 32, kb = item / nblk, nb = item % nblk, k0 = 64 * kb, n0 = 32 * nb;
#pragma unroll 8
    for (int i = 0; i < 32; ++i) { const int kk = 2 * i + (lane >> 5); scr[kk * 33 + (lane & 31)] = ((const GAS float*)W)[(size_t)(k0 + kk) * N + n0 + (lane & 31)]; }
    asm volatile("s_waitcnt lgkmcnt(0)" ::: "memory");
    const int c = lane & 7;
#pragma unroll
    for (int j = 0; j < 4; ++j) {
        const int n = (lane >> 3) + 8 * j; const float* s = scr + (8 * c) * 33 + n;
        u32x4 o; o.x = pk2(s[0 * 33], s[1 * 33]); o.y = pk2(s[2 * 33], s[3 * 33]); o.z = pk2(s[4 * 33], s[5 * 33]); o.w = pk2(s[6 * 33], s[7 * 33]);
        const int ng = n0 + n; const int drow = MODE == 0 ? ng : (ng < 2816 ? 2 * ng : 2 * (ng - 2816) + 1);
        *(GAS u32x4*)(WT + (size_t)drow * K + k0 + 8 * c) = o;
    }
    asm volatile("s_waitcnt lgkmcnt(0)" ::: "memory");
}
__device__ __forceinline__ void cvt_mix(ArgsP a, unsigned char* lds, int layer, int wb, int nb) {
    const int lane = OTID() & 63, wave = OTID() >> 6; float* scr = (float*)(lds + wave * 16384);
    const int gw = wb * 8 + wave, NGW = nb * 8;
    bf16_t* W1 = (bf16_t*)(WSP(a) + WS_WMIX); bf16_t* W2 = (bf16_t*)(WSP(a) + WS_WMIX2);
    if ((layer & 1) == 0) {
        const int i = layer >> 1; const float* win = AIN(I_WIN) + (size_t)i * 1024 * DIN; const float* wout = AIN(I_WOUT) + (size_t)i * 2048 * 1024;
        constexpr int I1 = (1024 / 64) * (DIN / 32), I2 = (2048 / 64) * (1024 / 32);
        for (int it = gw; it < I1 + I2; it += NGW) { if (it < I1) transpose_item<0>(win, 1024, DIN, W1, scr, it, lane); else transpose_item<0>(wout, 2048, 1024, W2, scr, it - I1, lane); }
    } else {
        const int j = layer >> 1; const float* wqkv = AIN(I_WQKV) + (size_t)j * 1024 * DQKV; const float* wo = AIN(I_WO) + (size_t)j * 1024 * 1024;
        constexpr int I1 = (1024 / 64) * (DQKV / 32), I2 = (1024 / 64) * (1024 / 32);
        for (int it = gw; it < I1 + I2; it += NGW) { if (it < I1) transpose_item<0>(wqkv, 1024, DQKV, W1, scr, it, lane); else transpose_item<0>(wo, 1024, 1024, W2, scr, it - I1, lane); }
    }
}
__device__ __forceinline__ void cvt_ffn(ArgsP a, unsigned char* lds, int layer, int wb, int nb) {
    const int lane = OTID() & 63, wave = OTID() >> 6; float* scr = (float*)(lds + wave * 16384);
    const int gw = wb * 8 + wave, NGW = nb * 8;
    const float* wgu = AIN(I_WGU) + (size_t)layer * 1024 * 2 * DFF; const float* wdn = AIN(I_WDN) + (size_t)layer * DFF * 1024;
    constexpr int I1 = (1024 / 64) * (2 * DFF / 32), I2 = (DFF / 64) * (1024 / 32);
    for (int it = gw; it < I1 + I2; it += NGW) { if (it < I1) transpose_item<1>(wgu, 1024, 2 * DFF, (bf16_t*)(WSP(a) + WS_WGU), scr, it, lane); else transpose_item<0>(wdn, DFF, 1024, (bf16_t*)(WSP(a) + WS_WDN), scr, it - I1, lane); }
}

__device__ __forceinline__ int bias_pairbase(int l) { return (l >> 1) * 17920 + (l & 1) * 10752; }
__device__ __forceinline__ int mix_n(int l) { return (l & 1) ? DQKV : DIN; }
__device__ __forceinline__ void bias_phase(ArgsP a, unsigned char* lds) {
    const int tid = OTID(), lane = tid & 63, wave = tid >> 6;
    float* cs = (float*)lds;
    const float* mods = (const float*)(WSP(a) + WS_MODS); float* bias = (float*)(WSP(a) + WS_BIAS);
    for (int unit = OBID(); unit < 140; unit += gridDim.x) {
        int l, r;
        if (unit < 42) { l = 0; r = unit; } else if (unit < 70) { l = 1; r = unit - 42; } else if (unit < 112) { l = 2; r = unit - 70; } else { l = 3; r = unit - 112; }
        const int nmixb = (l & 1) ? 6 : 20; const bool gu = r >= nmixb; const int n0 = (gu ? r - nmixb : r) * 256;
        const int N = gu ? 2 * DFF : mix_n(l);
        const float* Wb = gu ? AIN(I_WGU) + (size_t)l * 1024 * 2 * DFF : ((l & 1) ? AIN(I_WQKV) + (size_t)(l >> 1) * 1024 * DQKV : AIN(I_WIN) + (size_t)(l >> 1) * 1024 * DIN);
        const float* srcv = mods + (size_t)l * 17 * MODW + (gu ? 3072 : 0);
        float* outp = bias + (size_t)17 * (bias_pairbase(l) + (gu ? mix_n(l) : 0));
#pragma unroll 1
        for (int h2 = 0; h2 < 2; ++h2) { float tv[17];
#pragma unroll
            for (int q = 0; q < 17; ++q) { const int i = tid + 512 * (17 * h2 + q); tv[q] = ((const GAS float*)srcv)[(size_t)(i >> 10) * MODW + (i & 1023)]; }
#pragma unroll
            for (int q = 0; q < 17; ++q) cs[tid + 512 * (17 * h2 + q)] = tv[q]; }
        __syncthreads();
        const float* W = Wb + n0 + 4 * lane;
        f32x4 acc[17];
#pragma unroll
        for (int rr = 0; rr < 17; ++rr) acc[rr] = (f32x4){0.f, 0.f, 0.f, 0.f};
        gemv17_slice(acc, W, (size_t)N, cs, wave * 128);
        __syncthreads();
#pragma unroll
        for (int rr = 0; rr < 17; ++rr) *(f32x4*)(cs + ((wave * 17 + rr) * 256 + 4 * lane)) = acc[rr];
        __syncthreads();
        for (int i = tid; i < 17 * 256; i += 512) {
            const int rr = i >> 8, cc = i & 255; float sacc = 0.f;
#pragma unroll
            for (int w = 0; w < 8; ++w) sacc += cs[(w * 17 + rr) * 256 + cc];
            outp[(size_t)rr * N + n0 + cc] = sacc;
        }
        __syncthreads();
    }
}
__device__ __forceinline__ void xs_pass(ArgsP a, const float* xlat, const float* xctx, const float* g, const float* mods_l, int scoff, int wb, int nb) {
    const int lane = OTID() & 63, gw = wb * 8 + (OTID() >> 6), NGW = nb * 8;
    bf16_t* hm = (bf16_t*)(WSP(a) + WS_HMOD); float* ssq = (float*)(WSP(a) + WS_SSQ);
    for (int row0 = gw * 2; row0 < NTOK; row0 += NGW * 2) {
        f32x4 v[2][4];
#pragma unroll
        for (int q = 0; q < 2; ++q) { const int row = row0 + q; const float* xr = row < NLAT ? xlat + (size_t)row * 1024 : xctx + (size_t)(row - NLAT) * 1024;
#pragma unroll
            for (int j = 0; j < 4; ++j) v[q][j] = *(const f32x4*)(xr + 4 * lane + 256 * j); }
#pragma unroll
        for (int q = 0; q < 2; ++q) {
            const int row = row0 + q; const float* md = mods_l + (size_t)(row < NLAT ? (row >> 11) : 16) * MODW;
            float s = 0.f;
#pragma unroll
            for (int j = 0; j < 4; ++j) s += (v[q][j].x * v[q][j].x + v[q][j].y * v[q][j].y) + (v[q][j].z * v[q][j].z + v[q][j].w * v[q][j].w);
            s = wave_sum(s);
            if (lane < 16) ssq[(size_t)row * 16 + lane] = lane == 0 ? s : 0.f;
#pragma unroll
            for (int j = 0; j < 4; ++j) {
                const int c = 4 * lane + 256 * j;
                const f32x4 gg = *(const f32x4*)(g + c), sc = *(const f32x4*)(md + scoff + c);
                const f32x4 o = v[q][j] * gg * (sc + 1.f);
                u32x2 w; w.x = pk2(o.x, o.y); w.y = pk2(o.z, o.w);
                *(u32x2*)(hm + (size_t)row * 1024 + c) = w;
            }
        }
    }
}

__device__ __forceinline__ void norm_pass(ArgsP a, const float* xlat, const float* xctx, const float* g, const float* mods_l, int shoff, int scoff, int nrows) {
    const int lane = OTID() & 63, gw = OBID() * 8 + (OTID() >> 6), NGW = gridDim.x * 8;
    bf16_t* hm = (bf16_t*)(WSP(a) + WS_HMOD);
    for (int row = gw; row < nrows; row += NGW) {
        const float* xr = row < NLAT ? xlat + (size_t)row * 1024 : xctx + (size_t)(row - NLAT) * 1024;
        const float* md = mods_l + (size_t)(row < NLAT ? (row >> 11) : 16) * MODW;
        f32x4 v[4]; float s = 0.f;
#pragma unroll
        for (int j = 0; j < 4; ++j) { v[j] = *(const f32x4*)(xr + 4 * lane + 256 * j); s += (v[j].x * v[j].x + v[j].y * v[j].y) + (v[j].z * v[j].z + v[j].w * v[j].w); }
        const float rinv = rsqrtf(wave_sum(s) * (1.f / 1024.f) + 1e-6f);
#pragma unroll
        for (int j = 0; j < 4; ++j) {
            const int c = 4 * lane + 256 * j;
            const f32x4 gg = *(const f32x4*)(g + c), sc = *(const f32x4*)(md + scoff + c), sh = *(const f32x4*)(md + shoff + c);
            const f32x4 o = (v[j] * rinv) * gg * (sc + 1.f) + sh;
            u32x2 w; w.x = pk2(o.x, o.y); w.y = pk2(o.z, o.w);
            *(u32x2*)(hm + (size_t)row * 1024 + c) = w;
        }
    }
}
__device__ __forceinline__ void final_norm(ArgsP a) {
    const int lane = OTID() & 63, gw = OBID() * 8 + (OTID() >> 6), NGW = gridDim.x * 8;
    GAS float* outp = (GAS float*)a->out; const GAS float* fg = (const GAS float*)a->in[I_FG];
    for (int row0 = gw * 2; row0 < NLAT; row0 += NGW * 2) {
        f32x4 v[2][4];
#pragma unroll
        for (int q = 0; q < 2; ++q)
#pragma unroll
            for (int j = 0; j < 4; ++j) v[q][j] = *(const GAS f32x4*)(outp + (size_t)(row0 + q) * 1024 + 4 * lane + 256 * j);
#pragma unroll
        for (int q = 0; q < 2; ++q) {
            float s = 0.f;
#pragma unroll
            for (int j = 0; j < 4; ++j) s += (v[q][j].x * v[q][j].x + v[q][j].y * v[q][j].y) + (v[q][j].z * v[q][j].z + v[q][j].w * v[q][j].w);
            const float rinv = rsqrtf(wave_sum(s) * (1.f / 1024.f) + 1e-6f);
#pragma unroll
            for (int j = 0; j < 4; ++j) { const int c = 4 * lane + 256 * j; const f32x4 gg = *(const GAS f32x4*)(fg + c); *(GAS f32x4*)(outp + (size_t)(row0 + q) * 1024 + c) = (v[q][j] * rinv) * gg; }
        }
    }
}

template <int N_SEQ>
__device__ __forceinline__ void filt_out(ArgsP a, const float (&acc)[64], int colb, int chunk, int t, float tt, bool valid, int tid, int lane, int wave, float* inL, float* red) {
    const int dir = colb >> 11, order = (colb >> 10) & 1, c0 = colb & 1023;
    bf16_t* EF = (bf16_t*)(WSP(a) + (N_SEQ == 2048 ? WS_EF_LAT : WS_EF_CTX));
    float* SP = (float*)(WSP(a) + (N_SEQ == 2048 ? WS_SP_LAT : WS_SP_CTX));
    const bool use = valid && !(dir == 1 && t == 0);
    const int e = dir == 0 ? N_SEQ - t : N_SEQ + t;
    constexpr float MIN_DECAY = -3.0701134573253946f, MAX_DECAY = -15.350567286626973f;
    GAS bf16_t* ep = (GAS bf16_t*)EF + ((size_t)(order * 1024 + c0)) * (2 * N_SEQ);
#pragma unroll
    for (int j = 0; j < 64; ++j) {
        const int c = c0 + j;
        const float delta = fabsf(MIN_DECAY + (float)c * ((MAX_DECAY - MIN_DECAY) / 1023.f));
        const float val = acc[j] * __expf(-tt * delta);
        if (use) ep[e] = pg8::f2bf_rne(val);
        if (valid && dir == 0 && t == 0) ep[0] = 0;
        inL[j * 512 + tid] = use ? fabsf(val) : 0.f;
        ep += 2 * N_SEQ; asm volatile("" : "+v"(ep));
    }
    __syncthreads();
    {
        float sacc = 0.f;
#pragma unroll 8
        for (int k = 0; k < 64; ++k) sacc += inL[lane * 512 + wave * 64 + ((k + lane) & 63)];
        red[wave * 64 + lane] = sacc;
    }
    __syncthreads();
    if (tid < 64) { float s = 0.f;
#pragma unroll
        for (int w = 0; w < 8; ++w) s += red[w * 64 + tid];
        SP[chunk * 4096 + colb + tid] = s; }
    __syncthreads();
}
template <int N_SEQ>
__device__ __forceinline__ void filt_unit(ArgsP a, unsigned char* lds, int li, int chunk, int cb) {
    const int tid = OTID(), lane = tid & 63, wave = tid >> 6;
    float* inL = (float*)lds; float* Wl = (float*)(lds + 131072); float* vec = (float*)(lds + 147456); float* red = (float*)(lds + 148480);
    const float* w1 = AIN(I_FW1) + (size_t)li * 33 * 64; const float* w2 = AIN(I_FW2) + (size_t)li * 64 * 64; const float* w3 = AIN(I_FW3) + (size_t)li * 64 * 4096;
    const int t = chunk * 512 + tid; const bool valid = t < N_SEQ;
    const float tt = (float)t / (float)(N_SEQ - 1);
    const float wv = (6.283185307179586f / (float)N_SEQ) * (float)t;
    inL[tid] = tt;
#pragma unroll
    for (int j = 0; j < 16; ++j) { const float band = 1e-4f + (float)j * ((15.f - 1e-4f) / 15.f); const float ang = band * wv; inL[(1 + j) * 512 + tid] = __cosf(ang); inL[(17 + j) * 512 + tid] = -__sinf(ang); }
    for (int i = tid; i < 33 * 64; i += 512) Wl[i] = w1[i];
    if (tid < 64) { vec[tid] = AIN(I_FB1)[li * 64 + tid]; vec[64 + tid] = AIN(I_FB2)[li * 64 + tid]; vec[128 + tid] = AIN(I_FFREQ)[(li * 2 + 0) * 64 + tid]; vec[192 + tid] = AIN(I_FFREQ)[(li * 2 + 1) * 64 + tid]; }
    __syncthreads();
    float acc[64];
#pragma unroll
    for (int m = 0; m < 64; ++m) acc[m] = vec[m];
    for (int k = 0; k < 33; ++k) { const float x = inL[k * 512 + tid];
#pragma unroll
        for (int m4 = 0; m4 < 16; ++m4) { const f32x4 w = *(const f32x4*)(Wl + k * 64 + 4 * m4); acc[4 * m4] += x * w.x; acc[4 * m4 + 1] += x * w.y; acc[4 * m4 + 2] += x * w.z; acc[4 * m4 + 3] += x * w.w; } }
    __syncthreads();
#pragma unroll
    for (int m = 0; m < 64; ++m) inL[m * 512 + tid] = __sinf(vec[128 + m] * acc[m]);
    for (int i = tid; i < 64 * 64; i += 512) Wl[i] = w2[i];
    __syncthreads();
#pragma unroll
    for (int m = 0; m < 64; ++m) acc[m] = vec[64 + m];
    for (int k = 0; k < 64; ++k) { const float x = inL[k * 512 + tid];
#pragma unroll
        for (int m4 = 0; m4 < 16; ++m4) { const f32x4 w = *(const f32x4*)(Wl + k * 64 + 4 * m4); acc[4 * m4] += x * w.x; acc[4 * m4 + 1] += x * w.y; acc[4 * m4 + 2] += x * w.z; acc[4 * m4 + 3] += x * w.w; } }
    __syncthreads();
#pragma unroll
    for (int m = 0; m < 64; ++m) inL[m * 512 + tid] = __sinf(vec[192 + m] * acc[m]);
    for (int i = tid; i < 64 * 64; i += 512) Wl[i] = w3[(size_t)(i >> 6) * 4096 + cb * 128 + (i & 63)];
    __syncthreads();
#pragma unroll
    for (int m = 0; m < 64; ++m) acc[m] = 0.f;
    for (int k = 0; k < 64; ++k) { const float x = inL[k * 512 + tid];
#pragma unroll
        for (int m4 = 0; m4 < 16; ++m4) { const f32x4 w = *(const f32x4*)(Wl + k * 64 + 4 * m4); acc[4 * m4] += x * w.x; acc[4 * m4 + 1] += x * w.y; acc[4 * m4 + 2] += x * w.z; acc[4 * m4 + 3] += x * w.w; } }
    __syncthreads();
    for (int i = tid; i < 64 * 64; i += 512) Wl[i] = w3[(size_t)(i >> 6) * 4096 + cb * 128 + 64 + (i & 63)];
    __syncthreads();
    float acc2[64];
#pragma unroll
    for (int m = 0; m < 64; ++m) acc2[m] = 0.f;
    for (int k = 0; k < 64; ++k) { const float x = inL[k * 512 + tid];
#pragma unroll
        for (int m4 = 0; m4 < 16; ++m4) { const f32x4 w = *(const f32x4*)(Wl + k * 64 + 4 * m4); acc2[4 * m4] += x * w.x; acc2[4 * m4 + 1] += x * w.y; acc2[4 * m4 + 2] += x * w.z; acc2[4 * m4 + 3] += x * w.w; } }
    __syncthreads();
    filt_out<N_SEQ>(a, acc, cb * 128, chunk, t, tt, valid, tid, lane, wave, inL, red);
    filt_out<N_SEQ>(a, acc2, cb * 128 + 64, chunk, t, tt, valid, tid, lane, wave, inL, red);
}
__device__ __forceinline__ void filt_phase(ArgsP a, unsigned char* lds, int li, int wb, int nb, int u_lo = 0, int u_hi = 128 + 32) {
    for (int u = u_lo + wb; u < u_hi; u += nb) {
        if (u < 128) filt_unit<2048>(a, lds, li, u >> 5, u & 31); else filt_unit<256>(a, lds, li, 0, u - 128);
    }
}

__device__ __forceinline__ void gate_unit(ArgsP a, unsigned char* lds, int li, int unit, bf16_t* dstb, int dld) {
    const int tid = OTID(), lane = tid & 63, wave = tid >> 6;
    const int g = unit & 7, ch = unit >> 3;
    const int R0 = ch < 256 ? ch * 128 : NLAT + (ch - 256) * 128;
    bf16_t* UV = (bf16_t*)(WSP(a) + WS_BIG); const float* vst = (const float*)(WSP(a) + WS_VST);
    float* st = (float*)lds; bf16_t* vnT = (bf16_t*)(lds + 1024); constexpr int VLD = 136;
    const int i16 = lane & 15, kg = lane >> 4;
    f32x4 sp[8];
    if (tid < 128) {
#pragma unroll
        for (int i = 0; i < 8; ++i) sp[i] = *(const GAS f32x4*)(vst + (size_t)(R0 + tid) * 32 + 4 * i);
    }
    const int q = tid & 127;
    u32x4 raw[4]; f32x4 lgv[4][2], lbv[4][2];
#pragma unroll
    for (int it = 0; it < 4; ++it) {
        const int cc = ((tid >> 7) * 4 + it) * 8;
        raw[it] = *(const GAS u32x4*)(UV + (size_t)(R0 + q) * 2048 + 1024 + g * 128 + cc);
        const float* lg = AIN(I_LNG) + li * 1024 + g * 128 + cc; const float* lb = AIN(I_LNB) + li * 1024 + g * 128 + cc;
        lgv[it][0] = *(const GAS f32x4*)lg; lgv[it][1] = *(const GAS f32x4*)(lg + 4); lbv[it][0] = *(const GAS f32x4*)lb; lbv[it][1] = *(const GAS f32x4*)(lb + 4);
    }
    const float* Wsp = AIN(I_WS) + ((size_t)(li * 8 + g) * 128 + wave * 16 + i16) * 128 + kg * 8;
    f32x4 wq[4][2];
#pragma unroll
    for (int ks = 0; ks < 4; ++ks) { wq[ks][0] = *(const GAS f32x4*)(Wsp + ks * 32); wq[ks][1] = *(const GAS f32x4*)(Wsp + ks * 32 + 4); }
    const f32x4 bs4 = *(const GAS f32x4*)(AIN(I_BS) + (li * 8 + g) * 128 + wave * 16 + 4 * kg);
    u32x4 uraw[4];
#pragma unroll
    for (int j = 0; j < 4; ++j) uraw[j] = *(const GAS u32x4*)(UV + (size_t)(R0 + wave * 16 + 4 * kg + j) * 2048 + g * 128 + 8 * i16);
    if (tid < 128) {
        float sacc = 0.f, qacc = 0.f;
#pragma unroll
        for (int i = 0; i < 8; ++i) { sacc += sp[i][0] + sp[i][2]; qacc += sp[i][1] + sp[i][3]; }
        const float mean = sacc * (1.f / 1024.f); const float var = qacc * (1.f / 1024.f) - mean * mean;
        st[2 * tid] = mean; st[2 * tid + 1] = rsqrtf(fmaxf(var, 0.f) + 1e-5f);
    }
    __syncthreads();
    {
        const float mean = st[2 * q], rstd = st[2 * q + 1];
#pragma unroll
        for (int it = 0; it < 4; ++it) {
            const int cc = ((tid >> 7) * 4 + it) * 8;
            const unsigned rw[4] = {raw[it].x, raw[it].y, raw[it].z, raw[it].w};
#pragma unroll
            for (int e = 0; e < 4; ++e) {
                const float g0 = lgv[it][e >> 1][(2 * e) & 3], g1 = lgv[it][e >> 1][(2 * e + 1) & 3], b0 = lbv[it][e >> 1][(2 * e) & 3], b1 = lbv[it][e >> 1][(2 * e + 1) & 3];
                const float v0 = (bflo(rw[e]) - mean) * rstd * g0 + b0, v1 = (bfhi(rw[e]) - mean) * rstd * g1 + b1;
                vnT[(cc + 2 * e) * VLD + cc + q] = pg8::f2bf_rne(v0); vnT[(cc + 2 * e + 1) * VLD + cc + q] = pg8::f2bf_rne(v1);
            }
        }
    }
    __syncthreads();
    bf16x8 af[4];
#pragma unroll
    for (int ks = 0; ks < 4; ++ks) { const f32x4 w0 = wq[ks][0], w1 = wq[ks][1];
        u32x4 w; w.x = pk2(w0.x, w0.y); w.y = pk2(w0.z, w0.w); w.z = pk2(w1.x, w1.y); w.w = pk2(w1.z, w1.w); af[ks] = __builtin_bit_cast(bf16x8, w); }
    const float bsv[4] = {bs4[0], bs4[1], bs4[2], bs4[3]};
    f32x4 acc[8];
#pragma unroll
    for (int nt = 0; nt < 8; ++nt) {
        acc[nt] = (f32x4){0.f, 0.f, 0.f, 0.f};
#pragma unroll
        for (int ks = 0; ks < 4; ++ks) { const bf16x8 bfr = *(const bf16x8*)(vnT + (i16 * 8 + nt) * VLD + i16 * 8 + ks * 32 + kg * 8);     acc[nt] = __builtin_amdgcn_mfma_f32_16x16x32_bf16(af[ks], bfr, acc[nt], 0, 0, 0); }
    }
#pragma unroll
    for (int j = 0; j < 4; ++j) {
        const unsigned uw[4] = {uraw[j].x, uraw[j].y, uraw[j].z, uraw[j].w}; u32x4 o;
        o.x = pk2(bflo(uw[0]) * (acc[0][j] + bsv[j]), bfhi(uw[0]) * (acc[1][j] + bsv[j]));
        o.y = pk2(bflo(uw[1]) * (acc[2][j] + bsv[j]), bfhi(uw[1]) * (acc[3][j] + bsv[j]));
        o.z = pk2(bflo(uw[2]) * (acc[4][j] + bsv[j]), bfhi(uw[2]) * (acc[5][j] + bsv[j]));
        o.w = pk2(bflo(uw[3]) * (acc[6][j] + bsv[j]), bfhi(uw[3]) * (acc[7][j] + bsv[j]));
        *(GAS u32x4*)(dstb + (size_t)(R0 + wave * 16 + 4 * kg + j) * dld + g * 128 + 8 * i16) = o;
    }
    __syncthreads();
}

__device__ __forceinline__ void conv8(float (&o)[8], const u32x4 raw, float prev, float next, float w0, float w1, float w2, float bb) {
    float p[10]; p[0] = prev; p[1] = bflo(raw.x); p[2] = bfhi(raw.x); p[3] = bflo(raw.y); p[4] = bfhi(raw.y); p[5] = bflo(raw.z); p[6] = bfhi(raw.z); p[7] = bflo(raw.w); p[8] = bfhi(raw.w); p[9] = next;
#pragma unroll
    for (int e = 0; e < 8; ++e) o[e] = w0 * p[e] + w1 * p[e + 1] + w2 * p[e + 2] + bb;
}
template <int N_SEQ>
__device__ __forceinline__ void toeplitz_block(f32x4 (&acc)[8], const LAS unsigned char* Zt, const LAS unsigned char* E, int t0, int lane) {
    constexpr int ZROW = N_SEQ * 2 + 16;
    const int i = lane & 15, g = lane >> 4;
    const LAS unsigned char* ep = E + (N_SEQ - t0 - 8 * i + 8 * g) * 2;
    const LAS unsigned char* zp = Zt + i * ZROW + g * 16;
#pragma unroll
    for (int r = 0; r < 8; ++r) acc[r] = (f32x4){0.f, 0.f, 0.f, 0.f};
    bf16x8 bfr = *(const LAS bf16x8*)(zp);
    u32x4 lo = *(const LAS u32x4*)(ep - 16), hi = *(const LAS u32x4*)(ep);
#pragma unroll 2
    for (int s0 = 0; s0 < N_SEQ; s0 += 32) {
        const bf16x8 bfn = *(const LAS bf16x8*)(zp + s0 * 2 + 64);
        const u32x4 lon = *(const LAS u32x4*)(ep + s0 * 2 + 48), hin = *(const LAS u32x4*)(ep + s0 * 2 + 64);
        __builtin_amdgcn_sched_barrier(0);
        const unsigned w0 = lo.x, w1 = lo.y, w2 = lo.z, w3 = lo.w, w4 = hi.x, w5 = hi.y, w6 = hi.z, w7 = hi.w;
#define TP_EVEN(r, A, B, C, D) { u32x4 f; f.x = A; f.y = B; f.z = C; f.w = D; acc[r] = __builtin_amdgcn_mfma_f32_16x16x32_bf16(__builtin_bit_cast(bf16x8, f), bfr, acc[r], 0, 0, 0); }
#define TP_ODD(r, A, B, C, D, Eh) { u32x4 f; f.x = __builtin_amdgcn_alignbit(B, A, 16); f.y = __builtin_amdgcn_alignbit(C, B, 16); f.z = __builtin_amdgcn_alignbit(D, C, 16); f.w = __builtin_amdgcn_alignbit(Eh, D, 16); \
        acc[r] = __builtin_amdgcn_mfma_f32_16x16x32_bf16(__builtin_bit_cast(bf16x8, f), bfr, acc[r], 0, 0, 0); }
        __builtin_amdgcn_s_setprio(1);
        TP_EVEN(0, w4, w5, w6, w7)
        TP_ODD(1, w3, w4, w5, w6, w7)
        TP_EVEN(2, w3, w4, w5, w6)
        TP_ODD(3, w2, w3, w4, w5, w6)
        TP_EVEN(4, w2, w3, w4, w5)
        TP_ODD(5, w1, w2, w3, w4, w5)
        TP_EVEN(6, w1, w2, w3, w4)
        TP_ODD(7, w0, w1, w2, w3, w4)
        __builtin_amdgcn_s_setprio(0);
        __builtin_amdgcn_sched_barrier(0);
        bfr = bfn; lo = lon; hi = hin;
#undef TP_EVEN
#undef TP_ODD
    }
}
struct HyX { u32x4 raw[4]; float hprev, hnext; };
template <int N_SEQ>
__device__ __forceinline__ HyX hy_load(const bf16_t* xsrc, int tt) {
    HyX h;
#pragma unroll
    for (int j = 0; j < 4; ++j) h.raw[j] = *(const GAS u32x4*)(xsrc + tt + 8 * j);
    const GAS bf16_t* xg_ = (const GAS bf16_t*)xsrc; const float p = bf2f(xg_[tt > 0 ? tt - 1 : 0]), n = bf2f(xg_[tt + 32 < N_SEQ ? tt + 32 : N_SEQ - 1]);
    h.hprev = tt > 0 ? p : 0.f; h.hnext = tt + 32 < N_SEQ ? n : 0.f;
    return h;
}
template <int N_SEQ>
__device__ __forceinline__ void hy_epi(u32x4 (&zo)[4], const f32x4 (&acc)[8], const HyX& h, const LAS unsigned char* zrow  ,
                                       int tt, float w0, float w1, float w2, float bb, float invS, float skip) {
#pragma unroll
    for (int j = 0; j < 4; ++j) {
        const float prev = j == 0 ? h.hprev : bfhi(h.raw[j == 0 ? 0 : j - 1].w), next = j == 3 ? h.hnext : bflo(h.raw[j == 3 ? 3 : j + 1].x);
        float xg[8]; conv8(xg, h.raw[j], prev, next, w0, w1, w2, bb);
        const u32x4 zi = *(const LAS u32x4*)(zrow + (tt + 8 * j) * 2);
        const float zv[8] = {bflo(zi.x), bfhi(zi.x), bflo(zi.y), bfhi(zi.y), bflo(zi.z), bfhi(zi.z), bflo(zi.w), bfhi(zi.w)};
        float o[8];
#pragma unroll
        for (int r = 0; r < 8; ++r) o[r] = xg[r] * (acc[r][j] * invS + skip * zv[r]);
        zo[j].x = pk2(o[0], o[1]); zo[j].y = pk2(o[2], o[3]); zo[j].z = pk2(o[4], o[5]); zo[j].w = pk2(o[6], o[7]);
    }
}
template <int N_SEQ, int GROUPS>
__device__ __forceinline__ void hyena_job(ArgsP a, LAS unsigned char* lds0, int li, int cbase) {
    constexpr int ZROW = N_SEQ * 2 + 16, EB = 2 * N_SEQ * 2, NTH = 512 / GROUPS, WPG = 8 / GROUPS, NPASS = (N_SEQ / 128 + WPG - 1) / WPG, GSTRIDE = ((16 * ZROW + 2 * EB + 255) / 256) * 256 + 256;
    const int tid0 = OTID(), lane = tid0 & 63, tid = tid0 % NTH, grp = tid0 / NTH, wave = (tid0 >> 6) % WPG;
    const int c = cbase * GROUPS + grp;
    LAS unsigned char* lds = lds0 + grp * GSTRIDE;
    LAS unsigned char* Zt = lds; LAS unsigned char* E0 = lds + 16 * ZROW;
    const bf16_t* PT = (const bf16_t*)(WSP(a) + (N_SEQ == 2048 ? WS_PT_LAT : WS_PT_CTX));
    const unsigned char* EF = WSP(a) + (N_SEQ == 2048 ? WS_EF_LAT : WS_EF_CTX);
    const float* SP = (const float*)(WSP(a) + (N_SEQ == 2048 ? WS_SP_LAT : WS_SP_CTX));
    bf16_t* Z2 = (bf16_t*)(WSP(a) + (N_SEQ == 2048 ? WS_HMOD : WS_Z2T_CTX));
    for (int i = tid; i < 2 * EB / 16; i += NTH) { const int order = i / (EB / 16), off = i % (EB / 16);
        *(LAS u32x4*)(E0 + order * EB + off * 16) = *(const GAS u32x4*)(EF + (size_t)(order * 1024 + c) * EB + off * 16); }
    const float* cw = AIN(I_CW) + (size_t)li * 3 * 3072; const float* cbv = AIN(I_CB) + (size_t)li * 3072;
    {
        const float w0 = cw[c], w1 = cw[3072 + c], w2 = cw[2 * 3072 + c], bb = cbv[c];
        constexpr int NCH = (16 * N_SEQ / 8 + NTH - 1) / NTH;
        u32x4 raw[NCH]; unsigned short hp[NCH], hn[NCH];
#pragma unroll
        for (int q = 0; q < NCH; ++q) {
            const int ch = tid + NTH * q; const int b = ch / (N_SEQ / 8), tq = (ch % (N_SEQ / 8)) * 8;
            const bf16_t* src = PT + ((size_t)(b * 3072 + c)) * N_SEQ;
            const GAS bf16_t* sg_ = (const GAS bf16_t*)src; raw[q] = *(const GAS u32x4*)(src + tq); hp[q] = sg_[tq > 0 ? tq - 1 : 0]; hn[q] = sg_[tq + 8 < N_SEQ ? tq + 8 : N_SEQ - 1];
        }
#pragma unroll
        for (int q = 0; q < NCH; ++q) {
            const int ch = tid + NTH * q; const int b = ch / (N_SEQ / 8), tq = (ch % (N_SEQ / 8)) * 8;
            const float prev = tq > 0 ? bf2f(hp[q]) : 0.f, next = tq + 8 < N_SEQ ? bf2f(hn[q]) : 0.f;
            float o[8]; conv8(o, raw[q], prev, next, w0, w1, w2, bb);
            u32x4 w; w.x = pk2(o[0], o[1]); w.y = pk2(o[2], o[3]); w.z = pk2(o[4], o[5]); w.w = pk2(o[6], o[7]);
            *(LAS u32x4*)(Zt + b * ZROW + tq * 2) = w;
        }
    }
    float invS[2];
#pragma unroll
    for (int o = 0; o < 2; ++o) { float s = 0.f;
        for (int chn = 0; chn < (N_SEQ == 2048 ? 4 : 1); ++chn) s += ((const GAS float*)SP)[chn * 4096 + o * 1024 + c] + ((const GAS float*)SP)[chn * 4096 + 2048 + o * 1024 + c];
        invS[o] = 1.f / s; }
    const float skip0 = AIN(I_SKIP)[(li * 2 + 0) * 1024 + c], skip1 = AIN(I_SKIP)[(li * 2 + 1) * 1024 + c];
    __syncthreads();
    const int b = lane & 15, g = lane >> 4;
    const LAS unsigned char* zrow = Zt + b * ZROW;
    u32x4 z1p[NPASS][4];
    {
        const int col = 1024 + c; const float w0 = cw[col], w1 = cw[3072 + col], w2 = cw[2 * 3072 + col], bb = cbv[col];
        const bf16_t* xsrc = PT + ((size_t)(b * 3072 + col)) * N_SEQ;
#pragma unroll
        for (int ps = 0; ps < NPASS; ++ps) {
            const int t0 = (wave + WPG * ps) * 128;
            if (t0 < N_SEQ) { const HyX hx = hy_load<N_SEQ>(xsrc, t0 + 32 * g); f32x4 acc[8]; toeplitz_block<N_SEQ>(acc, Zt, E0, t0, lane); hy_epi<N_SEQ>(z1p[ps], acc, hx, zrow, t0 + 32 * g, w0, w1, w2, bb, invS[0], skip0); }
        }
    }
    __syncthreads();
#pragma unroll
    for (int ps = 0; ps < NPASS; ++ps) { const int t0 = (wave + WPG * ps) * 128;
        if (t0 < N_SEQ) {
#pragma unroll
            for (int j = 0; j < 4; ++j) *(LAS u32x4*)(Zt + b * ZROW + (t0 + 32 * g + 8 * j) * 2) = z1p[ps][j]; } }
    __syncthreads();
    {
        const int col = 2048 + c; const float w0 = cw[col], w1 = cw[3072 + col], w2 = cw[2 * 3072 + col], bb = cbv[col];
        const bf16_t* xsrc = PT + ((size_t)(b * 3072 + col)) * N_SEQ;
        bf16_t* zdst = Z2 + ((size_t)(b * 1024 + c)) * N_SEQ;
#pragma unroll
        for (int ps = 0; ps < NPASS; ++ps) {
            const int t0 = (wave + WPG * ps) * 128;
            if (t0 < N_SEQ) { const HyX hx = hy_load<N_SEQ>(xsrc, t0 + 32 * g); f32x4 acc[8]; toeplitz_block<N_SEQ>(acc, Zt, E0 + EB, t0, lane); u32x4 zo[4]; hy_epi<N_SEQ>(zo, acc, hx, zrow, t0 + 32 * g, w0, w1, w2, bb, invS[1], skip1);
#pragma unroll
                for (int j = 0; j < 4; ++j) *(GAS u32x4*)(zdst + t0 + 32 * g + 8 * j) = zo[j]; }
        }
    }
    __syncthreads();
}

__device__ __forceinline__ void z2_transpose(ArgsP a, unsigned char* lds) {
    const int lane = OTID() & 63, wave = OTID() >> 6, gw = OBID() * 8 + wave, NGW = gridDim.x * 8;
    unsigned* tl = (unsigned*)(lds + wave * 8704);
    bf16_t* cat = (bf16_t*)(WSP(a) + WS_BIG);
    constexpr int NT_LAT = 16 * 16 * 32, NT_CTX = 16 * 16 * 4;
    for (int it = gw; it < NT_LAT + NT_CTX; it += NGW) {
        int b, cbk, tbk, nseq; const bf16_t* src; size_t rowbase;
        if (it < NT_LAT) { b = it / (16 * 32); cbk = (it / 32) % 16; tbk = it % 32; nseq = 2048; src = (const bf16_t*)(WSP(a) + WS_HMOD); rowbase = (size_t)b * 2048; }
        else { const int i2 = it - NT_LAT; b = i2 / (16 * 4); cbk = (i2 / 4) % 16; tbk = i2 % 4; nseq = 256; src = (const bf16_t*)(WSP(a) + WS_Z2T_CTX); rowbase = (size_t)NLAT + (size_t)b * 256; }
        const bf16_t* sp = src + ((size_t)(b * 1024 + cbk * 64)) * nseq + tbk * 64;
#pragma unroll
        for (int i = 0; i < 8; ++i) { const int cr = 8 * i + (lane >> 3), chk = lane & 7; const u32x4 v = *(const GAS u32x4*)(sp + (size_t)cr * nseq + chk * 8);
            unsigned* d = tl + cr * 33 + chk * 4; d[0] = v.x; d[1] = v.y; d[2] = v.z; d[3] = v.w; }
        asm volatile("s_waitcnt lgkmcnt(0)" ::: "memory");
        const unsigned short* ts = (const unsigned short*)tl;
#pragma unroll
        for (int i = 0; i < 8; ++i) { const int tr = 8 * i + (lane >> 3), chk = lane & 7;
            unsigned short e[8];
#pragma unroll
            for (int k = 0; k < 8; ++k) e[k] = ts[(chk * 8 + k) * 66 + tr];
            u32x4 w; w.x = e[0] | ((unsigned)e[1] << 16); w.y = e[2] | ((unsigned)e[3] << 16); w.z = e[4] | ((unsigned)e[5] << 16); w.w = e[6] | ((unsigned)e[7] << 16);
            *(GAS u32x4*)(cat + (rowbase + tbk * 64 + tr) * 2048 + 1024 + cbk * 64 + chk * 8) = w; }
        asm volatile("s_waitcnt lgkmcnt(0)" ::: "memory");
    }
}

__device__ __forceinline__ void kprep_unit(ArgsP a, int j, int pm) {
    const int lane = OTID() & 63, wave = OTID() >> 6;
    bf16_t* Kb = (bf16_t*)(WSP(a) + WS_K);
    const int d0 = 2 * lane;
    const f32x2 kg = *(const GAS f32x2*)(AIN(I_KG) + j * 128 + d0);
    const int i0 = d0 & 63;
    const float inv0 = exp2f(-(float)(i0 & 31) * (13.287712379549449f / 32.f)), inv1 = exp2f(-(float)((i0 + 1) & 31) * (13.287712379549449f / 32.f));
    const bool second = lane >= 32, lat = pm < 128;
    const int kvrow0 = lat ? (pm >> 3) * SKV + CTXL + (pm & 7) * 256 : (pm - 128) * SKV, t0 = lat ? (pm & 7) * 256 : 0;
    for (int r0 = wave * 4; r0 < 256; r0 += 32) {
        unsigned raw[4][2]; GAS unsigned* kp[4];
#pragma unroll
        for (int q = 0; q < 4; ++q) { kp[q] = (GAS unsigned*)(Kb + (size_t)(kvrow0 + r0 + q) * 256) + lane; raw[q][0] = kp[q][0]; raw[q][1] = kp[q][64]; }
#pragma unroll
        for (int q = 0; q < 4; ++q) {
            float cs0 = 1.f, sn0 = 0.f, cs1 = 1.f, sn1 = 0.f;
            if (lat) { const int t = t0 + r0 + q; const float pos = (i0 < 32) ? (float)(t >> 6) : (float)(t & 63);
                cs0 = __cosf(pos * inv0); sn0 = __sinf(pos * inv0); cs1 = __cosf(pos * inv1); sn1 = __sinf(pos * inv1); }
            if (!second) { sn0 = -sn0; sn1 = -sn1; }
#pragma unroll
            for (int h = 0; h < 2; ++h) {
                float v0 = bflo(raw[q][h]), v1 = bfhi(raw[q][h]);
                const float rinv = rsqrtf(wave_sum(v0 * v0 + v1 * v1) * (1.f / 128.f) + 1e-6f);
                v0 *= rinv * kg.x; v1 *= rinv * kg.y;
                const float p0 = __shfl_xor(v0, 32), p1 = __shfl_xor(v1, 32);
                kp[q][h * 64] = pk2(v0 * cs0 + p0 * sn0, v1 * cs1 + p1 * sn1);
            }
        }
    }
}

#define RLX_AGENT __ATOMIC_RELAXED, __HIP_MEMORY_SCOPE_AGENT
constexpr size_t WS_BAR = 0x1D0000;
#define XB_TMO      128
#define XB_XCNT(j)  (256  + 64 * (j))
#define XB_XSUB(j)  (1280 + 64 * (j))
#define XB_XGEN(j)  (2304 + 64 * (j))
#define XB_TOP      3328
#define XB_TOPGEN   3392
#define XCD_BAR_WORDS 3456
#define XB_SPIN_CAP (1u << 18)

__device__ __forceinline__ unsigned xb_ld(unsigned* p)              { return __hip_atomic_load(p, __ATOMIC_RELAXED, __HIP_MEMORY_SCOPE_AGENT); }
__device__ __forceinline__ unsigned xb_add(unsigned* p, unsigned v) { return __hip_atomic_fetch_add(p, v, __ATOMIC_RELAXED, __HIP_MEMORY_SCOPE_AGENT); }
__device__ __forceinline__ unsigned xb_xcc_id() { return (unsigned)__builtin_amdgcn_s_getreg((3 << 11) | 20) & 0xFu; }
#define XB_SPIN(cond, bar) do { unsigned _sp = 0; while (cond) { __builtin_amdgcn_s_sleep(1); \
    if ((++_sp & 255u) == 0u) { if (xb_ld(&(bar)[XB_TMO])) break; if (_sp > XB_SPIN_CAP) { atomicAdd(&(bar)[XB_TMO], 1u); break; } } } } while (0)

struct XcdBarrier {
    unsigned* bar; unsigned x;
    volatile LAS unsigned* st;
};

__device__ __forceinline__ XcdBarrier xcd_barrier_post(unsigned* bar, volatile LAS unsigned* st) {
    XcdBarrier b; b.bar = bar; b.x = xb_xcc_id(); b.st = st;
    if (threadIdx.x == 0) (void)xb_add(&bar[XB_XCNT(b.x)], 1u);
    return b;
}
__device__ __forceinline__ void xcd_barrier_complete(unsigned* bar, unsigned x, unsigned& nloc, unsigned& nx) {
    const unsigned G = gridDim.x * gridDim.y * gridDim.z;
    unsigned sum, cnt, mine, sp = 0u;
    for (;;) {
        sum = 0u; cnt = 0u; mine = 0u;
#pragma unroll
        for (unsigned j = 0; j < 16; ++j) { const unsigned c = xb_ld(&bar[XB_XCNT(j)]); sum += c; cnt += (c > 0u) ? 1u : 0u; mine = (j == x) ? c : mine; }
        if (sum == G) break;
        __builtin_amdgcn_s_sleep(1);
        if ((++sp & 255u) == 0u) { if (xb_ld(&bar[XB_TMO])) break; if (sp > XB_SPIN_CAP) { atomicAdd(&bar[XB_TMO], 1u); break; } }
    }
    nloc = mine > 0u ? mine : 1u; nx = cnt > 0u ? cnt : 1u;
}

__device__ __forceinline__ void xcd_barrier(const XcdBarrier& b) {
    asm volatile("s_waitcnt vmcnt(0)" ::: "memory");
    __syncthreads();
    if (threadIdx.x == 0) {
        unsigned* bar = b.bar;
        __builtin_amdgcn_s_waitcnt(0);
        unsigned nloc = b.st[0], nx = b.st[1];
        if (nloc == 0u) { xcd_barrier_complete(bar, b.x, nloc, nx); b.st[0] = nloc; b.st[1] = nx; }
        const unsigned old = xb_add(&bar[XB_XSUB(b.x)], 1u);
        const unsigned gen = old / nloc;
        if (old + 1u == (gen + 1u) * nloc) {
            __builtin_amdgcn_fence(__ATOMIC_RELEASE, "agent");
            asm volatile("s_waitcnt vmcnt(0)" ::: "memory");
            const unsigned og = xb_add(&bar[XB_TOP], 1u);
            const unsigned tg = og / nx;
            if (og + 1u == (tg + 1u) * nx) xb_add(&bar[XB_TOPGEN], 1u);
            else XB_SPIN(xb_ld(&bar[XB_TOPGEN]) == tg, bar);
            __builtin_amdgcn_fence(__ATOMIC_ACQUIRE, "agent");
            xb_add(&bar[XB_XGEN(b.x)], 1u);
            asm volatile("s_waitcnt vmcnt(0)" ::: "memory");
        } else {
            XB_SPIN(xb_ld(&bar[XB_XGEN(b.x)]) == gen, bar);
            __builtin_amdgcn_fence(__ATOMIC_ACQUIRE, "agent");
            asm volatile("s_waitcnt vmcnt(0)" ::: "memory");
        }
    }
    __syncthreads();
}

struct LayerCtx { const float* mods_l; const float* xin_lat; const float* xin_ctx; float* xctx; bf16_t* hmod; float* dum_lat; float* dum_ctx; int Mres; bool last; };
__device__ __forceinline__ LayerCtx mk_ctx(ArgsP a, int l) {
    LayerCtx c; unsigned char* ws = WSP(a);
    c.mods_l = (const float*)(ws + WS_MODS) + (size_t)l * 17 * MODW;
    c.xctx = (float*)(ws + WS_XCTX); c.hmod = (bf16_t*)(ws + WS_HMOD);
    c.xin_lat = l == 0 ? AIN(I_X) : AOUT; c.xin_ctx = l == 0 ? AIN(I_CTX) : c.xctx;
    c.dum_lat = (float*)(ws + 328 * MiB); c.dum_ctx = (float*)(ws + 456 * MiB);
    c.last = l == 3; c.Mres = c.last ? NLAT : NTOK;
    return c;
}
#ifndef DUPMASK
#define DUPMASK 0
#endif
__global__ void __launch_bounds__(512, 2) mega_fwd(Args kargs) {
    extern __shared__ __attribute__((aligned(16))) unsigned char lds[];
    cg::grid_group grid = cg::this_grid();
    ArgsP a0 = (ArgsP)__builtin_amdgcn_kernarg_segment_ptr();
    int ph = 0;
    const int lo = kargs.ph_lo, hi = kargs.ph_hi;
    volatile LAS unsigned* bst = (volatile LAS unsigned*)((LAS unsigned char*)lds + (LDS_BYTES - 16));
    if (threadIdx.x == 0) { bst[0] = 0u; bst[1] = 0u; }
    __syncthreads();
    const XcdBarrier xbar = xcd_barrier_post((unsigned*)(kargs.ws + WS_BAR), bst);
    if (lo < 0) grid.sync();
#define PH_BEGIN(bit) if (ph >= lo && ph < hi) { ArgsP a = a0; asm volatile("" : "+s"(a)); int L = l; asm volatile("" : "+s"(L)); const LayerCtx c = mk_ctx(a, L); \
        LAS unsigned char* ldsl = (LAS unsigned char*)lds; const int G = gridDim.x, bx = OBID(); (void)c; (void)ldsl; (void)G; (void)bx; \
        for (int rep = ((DUPMASK >> (bit)) & 1) ? 0 : 1; rep < 2; ++rep) {
#define PH_END   if (ph + 1 < hi || rep == 0) xcd_barrier(xbar); } } ++ph;
#define PH_END_NB } } ++ph;

    int l = 0;
    PH_BEGIN(11)
        if (bx < 96 || G < 192) phase_mods(a, lds);
        { const bool sp = G >= 192; const int wb = sp ? bx - 96 : bx, nb = sp ? G - 96 : G; if (wb >= 0) { __syncthreads(); cvt_mix(a, lds, 0, wb, nb); __syncthreads(); filt_phase(a, lds, 0, wb, nb); } }
    PH_END

    PH_BEGIN(0)
        bias_phase(a, lds);
        if (G > 140) {
            const int nvw = 140 + 3 * (G - 140);
            if (bx < 140) xs_pass(a, AIN(I_X), AIN(I_CTX), AIN(I_N1G), c.mods_l, 1024, bx, nvw);
            else for (int q = 0; q < 3; ++q) xs_pass(a, AIN(I_X), AIN(I_CTX), AIN(I_N1G), c.mods_l, 1024, 140 + 3 * (bx - 140) + q, nvw);
        } else xs_pass(a, AIN(I_X), AIN(I_CTX), AIN(I_N1G), c.mods_l, 1024, bx, G);
    PH_END
#pragma unroll 1
    for (l = 0; l < 4; ++l) {
        if ((l & 1) == 0) {
            PH_BEGIN(2)
                pg8::Gemm gm{c.hmod, (const bf16_t*)(WSP(a) + WS_WMIX), NTOK, DIN, 1024}; pg8::StaticOrder S; S.init(NTOK, DIN, G, bx);
                pg8::EpiE1 E{(bf16_t*)(WSP(a) + WS_BIG), (float*)(WSP(a) + WS_VST), (bf16_t*)(WSP(a) + WS_PT_LAT), (bf16_t*)(WSP(a) + WS_PT_CTX), (const float*)(WSP(a) + WS_SSQ), (const float*)(WSP(a) + WS_BIAS) + (size_t)17 * bias_pairbase(L)};
                pg8::gemm_phase<pg8::EpiE1, pg8::StaticOrder, true, true>(ldsl, gm, S, E);
            PH_END
            PH_BEGIN(3)
                const int li = L >> 1;
                if (rep == 1) { for (int ch = bx; ch < 1024; ch += G) hyena_job<2048, 1>(a, ldsl, li, ch);
                    for (int ch = bx; ch < 256; ch += G) hyena_job<256, 4>(a, ldsl, li, ch); }
                for (int u = bx; u < 288 * 8; u += G) gate_unit(a, lds, li, u, rep == 1 ? (bf16_t*)(WSP(a) + WS_BIG) : c.hmod, rep == 1 ? 2048 : 1024);
            PH_END
            PH_BEGIN(4)
                z2_transpose(a, lds);
            PH_END
        } else {
            PH_BEGIN(6)
                pg8::Gemm gm{c.hmod, (const bf16_t*)(WSP(a) + WS_WMIX), NTOK, DQKV, 1024}; pg8::StaticOrder S; S.init(NTOK, DQKV, G, bx);
                pg8::EpiQKV E{(bf16_t*)(WSP(a) + WS_Q), (bf16_t*)(WSP(a) + WS_K), (bf16_t*)(WSP(a) + WS_V), (const float*)(WSP(a) + WS_SSQ), (const float*)(WSP(a) + WS_BIAS) + (size_t)17 * bias_pairbase(L)};
                pg8::gemm_phase<pg8::EpiQKV, pg8::StaticOrder, true, true>(ldsl, gm, S, E);
            PH_END_NB
            PH_BEGIN(7)
                asm volatile("s_waitcnt vmcnt(0)" ::: "memory"); __syncthreads();
                { pg8::StaticOrder S2; S2.init(NTOK, DQKV, G, bx); pg8::Unit ku; for (int i = 0; S2.next(i, ku); ++i) if (ku.pn == 4) kprep_unit(a, L >> 1, ku.pm); }
            PH_END
            PH_BEGIN(8)
                const att::bf16* Q = (const att::bf16*)(WSP(a) + WS_Q); const att::bf16* Kb = (const att::bf16*)(WSP(a) + WS_K); const att::bf16* Vb = (const att::bf16*)(WSP(a) + WS_V); att::bf16* O = (att::bf16*)(WSP(a) + WS_O);
                const int nun = c.last ? 1024 : 1024 + 128;
                const int vbx = (G % 8 == 0) ? (bx % 8) * (G / 8) + bx / 8 : bx;
                for (int u = vbx; u < nun; u += G) {
                    const bool isl = u < 1024; const int v = u - 1024;
                    const int h = isl ? (u >> 3) & 7 : v & 7, b = isl ? u >> 6 : v >> 3;
                    const size_t r0 = isl ? (size_t)b * 2048 + (u & 7) * 256 : (size_t)NLAT + (size_t)b * 256;
                    const size_t kv0 = (size_t)b * SKV * 256 + (h >> 2) * 128;
                    att::attn_dense_body<att::bf16>(Q + r0 * 1024 + h * 128, Kb + kv0, Vb + kv0, O + r0 * 1024 + h * 128, isl ? SKV : CTXL, (char*)lds, AIN(I_QG) + (L >> 1) * 128, isl ? (u & 7) * 256 : -1);
                    __syncthreads();
                }
            PH_END
        }
        PH_BEGIN(5)
            const bool ev = (L & 1) == 0;
            pg8::Gemm gm{(const bf16_t*)(WSP(a) + (ev ? WS_BIG : WS_O)), (const bf16_t*)(WSP(a) + WS_WMIX2), c.Mres, 1024, ev ? 2048 : 1024}; pg8::StaticOrder S; S.init(c.Mres, 1024, G, bx);
            pg8::EpiRes E{c.xin_lat, c.xin_ctx, rep == 0 ? c.dum_lat : AOUT, rep == 0 ? c.dum_ctx : c.xctx, c.mods_l + 2048, AIN(I_N2G) + L * 1024, c.mods_l + 4096, c.hmod, (float*)(WSP(a) + WS_SSQ)};
            pg8::gemm_phase<pg8::EpiRes, pg8::StaticOrder, true, true>(ldsl, gm, S, E);
            if (rep == 1) { const int rem = ((c.Mres / 256) * 4) % G, wb = rem ? bx - rem : bx, nb = rem ? G - rem : G;
                if (wb >= 0) { __syncthreads(); cvt_ffn(a, lds, L, wb, nb); } }
        PH_END
        PH_BEGIN(9)
            pg8::Gemm gm{c.hmod, (const bf16_t*)(WSP(a) + WS_WGU), c.Mres, 2 * DFF, 1024}; pg8::StaticOrder S; S.init(c.Mres, 2 * DFF, G, bx);
            pg8::EpiSwiGLU E{(bf16_t*)(WSP(a) + WS_BIG), (const float*)(WSP(a) + WS_SSQ), (const float*)(WSP(a) + WS_BIAS) + (size_t)17 * (bias_pairbase(L) + mix_n(L))};
            pg8::gemm_phase<pg8::EpiSwiGLU, pg8::StaticOrder, true, true>(ldsl, gm, S, E);
        PH_END
        PH_BEGIN(10)
            pg8::Gemm gm{(const bf16_t*)(WSP(a) + WS_BIG), (const bf16_t*)(WSP(a) + WS_WDN), c.Mres, 1024, DFF}; pg8::StaticOrder S; S.init(c.Mres, 1024, G, bx);
            pg8::EpiRes E{AOUT, c.xctx, rep == 0 ? c.dum_lat : AOUT, rep == 0 ? c.dum_ctx : c.xctx, c.mods_l + 5120, c.last ? (const float*)nullptr : AIN(I_N1G) + (L + 1) * 1024, c.mods_l + 17 * MODW + 1024, c.hmod, (float*)(WSP(a) + WS_SSQ)};
            pg8::gemm_phase<pg8::EpiRes, pg8::StaticOrder, true, true>(ldsl, gm, S, E);
            if (rep == 1 && !c.last) { const int rem = ((c.Mres / 256) * 4) % G, wb = rem ? bx - rem : bx, nb = rem ? G - rem : G;
                if (wb >= 0) { __syncthreads(); cvt_mix(a, lds, L + 1, wb, nb); if (L < 2) { __syncthreads(); filt_phase(a, lds, 1, wb, nb, L == 0 ? 0 : 80, L == 0 ? 80 : 160); } } }
        PH_END
    }
    PH_BEGIN(12)
        final_norm(a);
    PH_END
#undef PH_BEGIN
#undef PH_END
#undef PH_END_NB
}
constexpr int N_PHASES = 2 + 4 * 6 + 1;

extern "C" void kernel_launch(void* const* d_in, const int* in_sizes, int n_in, void* d_out, int out_size, void* d_ws, size_t ws_size, hipStream_t stream) {
    static int grid = 0;
    if (grid == 0) {
        if (n_in != 30 || out_size != NLAT * DM || ws_size < WS_END) { fprintf(stderr, "kernel_launch: unexpected shapes: n_in %d out %d ws %zu (need %zu)\n", n_in, out_size, ws_size, (size_t)WS_END); grid = -1; return; }
        int dev = 0, cus = 0, per_cu = 0;
        hipGetDevice(&dev); hipDeviceGetAttribute(&cus, hipDeviceAttributeMultiprocessorCount, dev);
        if (hipFuncSetAttribute((const void*)mega_fwd, hipFuncAttributeMaxDynamicSharedMemorySize, LDS_BYTES) != hipSuccess) { fprintf(stderr, "kernel_launch: hipFuncSetAttribute failed\n"); grid = -1; return; }
        if (hipOccupancyMaxActiveBlocksPerMultiprocessor(&per_cu, (const void*)mega_fwd, 512, LDS_BYTES) != hipSuccess || per_cu < 1) { fprintf(stderr, "kernel_launch: occupancy query says %d\n", per_cu); per_cu = 1; }
        (void)hipGetLastError();
        grid = cus * 1;
        fprintf(stderr, "kernel_launch: cus %d per_cu %d grid %d ws %zu\n", cus, per_cu, grid, ws_size);
    }
    if (grid < 0) return;
    Args a{};
    for (int i = 0; i < 30; ++i) a.in[i] = (const float*)d_in[i];
    a.out = (float*)d_out; a.ws = (unsigned char*)d_ws; a.ph_lo = 0; a.ph_hi = N_PHASES;
    if (hipMemsetAsync((char*)d_ws + WS_BAR, 0, 16384, stream) != hipSuccess) { fprintf(stderr, "kernel_launch: memset failed\n"); return; }
    void* args[] = {&a};
    hipError_t e = hipLaunchCooperativeKernel((const void*)mega_fwd, dim3(grid), dim3(512), args, LDS_BYTES, stream);
    if (e != hipSuccess) fprintf(stderr, "kernel_launch: cooperative launch failed: %s\n", hipGetErrorString(e));
}
```
